# Optimizing an MI355X kernel written in HIP

```python
import math
import jax, jax.numpy as jnp
from jax import lax
import numpy as np

D_MODEL = 1024
BATCH = 2
SEQ = 8192
DEPTH = 2

N_A_LAYERS = DEPTH // 2
N_B_LAYERS = DEPTH - N_A_LAYERS
LRU_WIDTH = 1280
LRU_BLOCK = 256
LRU_HEADS = LRU_WIDTH // LRU_BLOCK
CONV_WIDTH = 4
LRU_C = 8.0
N_HEADS = 8
N_KV_HEADS = 4
HEAD_DIM = 128
KV_GROUP = N_HEADS // N_KV_HEADS
MOBA_BLOCK = 256
MOBA_TOPK = 3
Q_CHUNK = 16
REL_BUCKETS = 32
REL_MAX_DIST = 128
D_FF = -(-8 * D_MODEL // (3 * 256)) * 256
RMS_EPS = 1e-6
NEG_INF = -1e30

kernel_name = "yoco_rglru_moba_adaln_trunk"


def rmsnorm(x, g):
    xf = x.astype(jnp.float32)
    y = xf * lax.rsqrt(jnp.mean(xf * xf, axis=-1, keepdims=True) + RMS_EPS)
    return (y * g.astype(jnp.float32)).astype(x.dtype)


def modulate(h, shift, scale):
    return h * (1 + scale[:, None, :]) + shift[:, None, :]


def swiglu(h, w_gate, w_up, w_down):
    return (jax.nn.silu(h @ w_gate) * (h @ w_up)) @ w_down


def _lru_combine(left, right):
    a_l, b_l = left
    a_r, b_r = right
    return a_l * a_r, a_r * b_l + b_r


def rglru_mixer(h, w_in, conv_w, conv_b, w_gates, b_gates, lru_lambda, w_out):
    B, S, _ = h.shape
    u = h @ w_in
    y_br = jax.nn.gelu(u[..., :LRU_WIDTH])
    x_br = u[..., LRU_WIDTH:]
    xp = jnp.pad(x_br, ((0, 0), (CONV_WIDTH - 1, 0), (0, 0)))
    xc = sum(xp[:, k:k + S, :] * conv_w[k] for k in range(CONV_WIDTH)) + conv_b
    xb = xc.reshape(B, S, LRU_HEADS, LRU_BLOCK)
    g = jnp.einsum('bshi,hio->bsho', xb, w_gates)
    gr = g[..., :LRU_BLOCK].reshape(B, S, LRU_WIDTH) + b_gates[0]
    gi = g[..., LRU_BLOCK:].reshape(B, S, LRU_WIDTH) + b_gates[1]
    r = jax.nn.sigmoid(gr.astype(jnp.float32))
    i = jax.nn.sigmoid(gi.astype(jnp.float32))
    log_a = -LRU_C * r * jax.nn.softplus(-lru_lambda.astype(jnp.float32))
    a = jnp.exp(log_a)
    mult = jnp.sqrt(-jnp.expm1(2.0 * log_a))
    b = mult * (i * xc.astype(jnp.float32))
    _, hs = lax.associative_scan(_lru_combine, (a, b), axis=1)
    return (hs.astype(h.dtype) * y_br) @ w_out


def shared_kv(x, shift, scale, g, w_kv):
    B, S, _ = x.shape
    h = modulate(rmsnorm(x, g), shift, scale)
    kv = h @ w_kv
    nb = -(-S // MOBA_BLOCK)
    pad = nb * MOBA_BLOCK - S
    def blk(t):
        t = t.reshape(B, S, N_KV_HEADS, HEAD_DIM).transpose(0, 2, 1, 3)
        t = jnp.pad(t, ((0, 0), (0, 0), (0, pad), (0, 0)))
        return t.reshape(B, N_KV_HEADS, nb, MOBA_BLOCK, HEAD_DIM)
    k_blocks = blk(kv[..., :N_KV_HEADS * HEAD_DIM])
    v_blocks = blk(kv[..., N_KV_HEADS * HEAD_DIM:])
    k_mean = jnp.mean(k_blocks.astype(jnp.float32), axis=3)
    return k_blocks, v_blocks, k_mean


def t5_bucket(dist):
    dist = jnp.maximum(dist, 0)
    max_exact = REL_BUCKETS // 2
    d = jnp.maximum(dist, 1).astype(jnp.float32)
    large = max_exact + (jnp.log(d / max_exact) / math.log(REL_MAX_DIST / max_exact)
                         * (REL_BUCKETS - max_exact)).astype(jnp.int32)
    large = jnp.minimum(large, REL_BUCKETS - 1)
    return jnp.where(dist < max_exact, dist, large)


def moba_mixer(h, w_q, w_o, k_blocks, v_blocks, k_mean, rel_bias):
    B, S, _ = h.shape
    nb = k_blocks.shape[2]
    s_pad = nb * MOBA_BLOCK
    n_sel = min(MOBA_TOPK, nb)
    scale = HEAD_DIM ** -0.5
    q = (h @ w_q).reshape(B, S, N_HEADS, HEAD_DIM).transpose(0, 2, 1, 3)
    q = jnp.pad(q, ((0, 0), (0, 0), (0, s_pad - S), (0, 0)))
    kv_head = jnp.arange(N_HEADS) // KV_GROUP
    km = k_mean[:, kv_head]
    bi = jnp.arange(B)[:, None, None, None]
    kvh = kv_head[None, :, None, None]
    hi5 = jnp.arange(N_HEADS)[None, :, None, None, None]
    bias_tab = rel_bias.astype(jnp.float32)
    blk_pos = jnp.arange(MOBA_BLOCK)

    def chunk(ci):
        t0 = ci * Q_CHUNK
        qf = lax.dynamic_slice_in_dim(q, t0, Q_CHUNK, axis=2).astype(jnp.float32)
        pos = t0 + jnp.arange(Q_CHUNK)
        own = t0 // MOBA_BLOCK
        gate = jnp.einsum('bhcd,bhnd->bhcn', qf, km)
        gate = jnp.where(jnp.arange(nb) < own, gate, NEG_INF)
        _, idx = lax.top_k(gate, n_sel)
        sel_valid = jnp.arange(n_sel) < own
        ksel = k_blocks[bi, kvh, idx].astype(jnp.float32)
        vsel = v_blocks[bi, kvh, idx].astype(jnp.float32)
        s_sel = jnp.einsum('bhcd,bhcnkd->bhcnk', qf, ksel) * scale
        kpos_sel = idx[..., None] * MOBA_BLOCK + blk_pos
        dist_sel = pos[None, None, :, None, None] - kpos_sel
        s_sel = jnp.where(sel_valid[:, None], s_sel + bias_tab[hi5, t5_bucket(dist_sel)], NEG_INF)
        k_own = lax.dynamic_index_in_dim(k_blocks, own, axis=2, keepdims=False)[:, kv_head].astype(jnp.float32)
        v_own = lax.dynamic_index_in_dim(v_blocks, own, axis=2, keepdims=False)[:, kv_head].astype(jnp.float32)
        s_own = jnp.einsum('bhcd,bhkd->bhck', qf, k_own) * scale
        dist_own = pos[:, None] - (own * MOBA_BLOCK + blk_pos)[None, :]
        s_own = jnp.where(dist_own >= 0, s_own + bias_tab[:, t5_bucket(dist_own)], NEG_INF)
        logits = jnp.concatenate([s_sel.reshape(B, N_HEADS, Q_CHUNK, n_sel * MOBA_BLOCK), s_own], axis=-1)
        p = jax.nn.softmax(logits, axis=-1)
        p_sel = p[..., :n_sel * MOBA_BLOCK].reshape(B, N_HEADS, Q_CHUNK, n_sel, MOBA_BLOCK)
        p_own = p[..., n_sel * MOBA_BLOCK:]
        o = jnp.einsum('bhcnk,bhcnkd->bhcd', p_sel, vsel) + jnp.einsum('bhck,bhkd->bhcd', p_own, v_own)
        return o.astype(h.dtype)

    o = lax.map(chunk, jnp.arange(s_pad // Q_CHUNK))
    o = o.transpose(1, 0, 3, 2, 4).reshape(B, s_pad, N_HEADS * HEAD_DIM)[:, :S]
    return o @ w_o


def setup_inputs(seed: int = 0) -> dict:
    key = jax.random.key(seed)
    ks = jax.random.split(key, 32)
    nrm = lambda k, shape, s: jax.random.normal(k, shape, jnp.float32) * s
    D = D_MODEL
    u = jax.random.uniform(ks[10], (N_A_LAYERS, LRU_WIDTH), jnp.float32, 0.9, 0.999)
    a_base = u ** (1.0 / LRU_C)
    lru_lambda = jnp.log(a_base) - jnp.log1p(-a_base)
    return {
        "x": nrm(ks[0], (BATCH, SEQ, D), 1.0),
        "c": nrm(ks[1], (BATCH, D), 1.0),
        "mod_w": nrm(ks[2], (DEPTH, D, 6 * D), 0.5 * D ** -0.5),
        "mod_b": nrm(ks[3], (DEPTH, 6 * D), 0.02),
        "norm_mix": 1.0 + nrm(ks[4], (DEPTH, D), 0.02),
        "norm_ffn": 1.0 + nrm(ks[5], (DEPTH, D), 0.02),
        "lru_w_in": nrm(ks[6], (N_A_LAYERS, D, 2 * LRU_WIDTH), D ** -0.5),
        "lru_conv_w": nrm(ks[7], (N_A_LAYERS, CONV_WIDTH, LRU_WIDTH), CONV_WIDTH ** -0.5),
        "lru_conv_b": nrm(ks[8], (N_A_LAYERS, LRU_WIDTH), 0.02),
        "lru_w_gates": nrm(ks[9], (N_A_LAYERS, LRU_HEADS, LRU_BLOCK, 2 * LRU_BLOCK), LRU_BLOCK ** -0.5),
        "lru_b_gates": nrm(ks[11], (N_A_LAYERS, 2, LRU_WIDTH), 0.02),
        "lru_lambda": lru_lambda,
        "lru_w_out": nrm(ks[12], (N_A_LAYERS, LRU_WIDTH, D), LRU_WIDTH ** -0.5),
        "kv_mod_w": nrm(ks[13], (D, 2 * D), 0.5 * D ** -0.5),
        "kv_mod_b": nrm(ks[14], (2 * D,), 0.02),
        "kv_norm": 1.0 + nrm(ks[15], (D,), 0.02),
        "w_kv": nrm(ks[16], (D, 2 * N_KV_HEADS * HEAD_DIM), D ** -0.5),
        "attn_w_q": nrm(ks[17], (N_B_LAYERS, D, N_HEADS * HEAD_DIM), D ** -0.5),
        "attn_w_o": nrm(ks[18], (N_B_LAYERS, N_HEADS * HEAD_DIM, D), (N_HEADS * HEAD_DIM) ** -0.5),
        "rel_bias": nrm(ks[19], (N_HEADS, REL_BUCKETS), 0.2),
        "ffn_w_gate": nrm(ks[20], (DEPTH, D, D_FF), D ** -0.5),
        "ffn_w_up": nrm(ks[21], (DEPTH, D, D_FF), D ** -0.5),
        "ffn_w_down": nrm(ks[22], (DEPTH, D_FF, D), D_FF ** -0.5),
        "final_norm": 1.0 + nrm(ks[23], (D,), 0.02),
    }


def reference(x, c, mod_w, mod_b, norm_mix, norm_ffn, lru_w_in, lru_conv_w, lru_conv_b,
              lru_w_gates, lru_b_gates, lru_lambda, lru_w_out, kv_mod_w, kv_mod_b, kv_norm,
              w_kv, attn_w_q, attn_w_o, rel_bias, ffn_w_gate, ffn_w_up, ffn_w_down, final_norm):
    D = D_MODEL
    cs = jax.nn.silu(c)
    kv = None
    for l in range(DEPTH):
        if l == N_A_LAYERS:
            kv_mod = cs @ kv_mod_w + kv_mod_b
            kv = shared_kv(x, kv_mod[:, :D], kv_mod[:, D:], kv_norm, w_kv)
        mod = cs @ mod_w[l] + mod_b[l]
        sh_m, sc_m, g_m = mod[:, :D], mod[:, D:2 * D], mod[:, 2 * D:3 * D]
        sh_f, sc_f, g_f = mod[:, 3 * D:4 * D], mod[:, 4 * D:5 * D], mod[:, 5 * D:]
        h = modulate(rmsnorm(x, norm_mix[l]), sh_m, sc_m)
        if l < N_A_LAYERS:
            mix = rglru_mixer(h, lru_w_in[l], lru_conv_w[l], lru_conv_b[l], lru_w_gates[l],
                              lru_b_gates[l], lru_lambda[l], lru_w_out[l])
        else:
            j = l - N_A_LAYERS
            mix = moba_mixer(h, attn_w_q[j], attn_w_o[j], kv[0], kv[1], kv[2], rel_bias)
        x = x + g_m[:, None, :] * mix
        h = modulate(rmsnorm(x, norm_ffn[l]), sh_f, sc_f)
        x = x + g_f[:, None, :] * swiglu(h, ffn_w_gate[l], ffn_w_up[l], ffn_w_down[l])
    return rmsnorm(x, final_norm)
```

```cpp
#include <hip/hip_runtime.h>
#include <cstdio>
#include <cstdint>
#include <cstddef>

#ifndef MK_N_LAUNCHES
#define MK_N_LAUNCHES 1
#endif

#define DRY_VARIANT 2
#define REPEAT_SET 0x0u
#define GAS __attribute__((address_space(1)))
#define LAS __attribute__((address_space(3)))
typedef unsigned short bf16;
typedef short bf16x8 __attribute__((ext_vector_type(8)));
typedef float f32x2 __attribute__((ext_vector_type(2)));
typedef float f32x4 __attribute__((ext_vector_type(4)));
typedef float f32x16 __attribute__((ext_vector_type(16)));
typedef unsigned u32x2 __attribute__((ext_vector_type(2)));
typedef unsigned u32x4 __attribute__((ext_vector_type(4)));
typedef __bf16 bf16x2_t __attribute__((ext_vector_type(2)));
typedef GAS unsigned gu32;

__device__ __forceinline__ unsigned pk2(float lo, float hi) { f32x2 v = {lo, hi}; return __builtin_bit_cast(unsigned, __builtin_convertvector(v, bf16x2_t)); }
__device__ __forceinline__ float bflo(unsigned u) { return __uint_as_float(u << 16); }
__device__ __forceinline__ float bfhi(unsigned u) { return __uint_as_float(u & 0xffff0000u); }
__device__ __forceinline__ void unpack8(const u32x4 v, float (&x)[8]) { x[0] = bflo(v.x); x[1] = bfhi(v.x); x[2] = bflo(v.y); x[3] = bfhi(v.y); x[4] = bflo(v.z); x[5] = bfhi(v.z); x[6] = bflo(v.w); x[7] = bfhi(v.w); }
__device__ __forceinline__ float fexp2(float x) { return __builtin_amdgcn_exp2f(x); }
__device__ __forceinline__ float frcp(float x) { return __builtin_amdgcn_rcpf(x); }
#define LOG2E 1.4426950408889634f

constexpr int BATCH = 2, SEQ = 8192, D = 1024, M = BATCH * SEQ;
constexpr int LW = 1280, LH = 5, LB = 256;
constexpr int FF = 2816;
constexpr int NH = 8, NKV = 4, HD = 128, BLK = 256, NB = SEQ / BLK;
constexpr float RMS_EPS = 1e-6f;

namespace pg8 {
constexpr int BM = 256, BK = 64, HALF = 128, HTB = HALF * BK * 2, STAGE_BYTES = 8 * HTB, NXCD = 8, WGM = 8;
__host__ __device__ __forceinline__ int lds_byte(int r, int c) { const int st = (r >> 4) * 2 + (c >> 5), rr = r & 15, cc = c & 31, ob = rr * 64 + cc * 2; return st * 1024 + (ob ^ (((ob >> 9) & 1) << 5)); }
__host__ __device__ __forceinline__ void stage_rc(int b, int& R, int& C) { const int st = b / 1024, sb = b % 1024, swz = sb ^ (((sb >> 9) & 1) << 5); R = (st >> 1) * 16 + swz / 64; C = (st & 1) * 32 + (swz % 64) / 2; }
__host__ __device__ __forceinline__ int perm32(int rho) { const int n = rho >> 4, i = rho & 15; return 8 * (i >> 2) + 4 * n + (i & 3); }

struct Unit { int pm, pn, acol; };
struct Gemm { const bf16* A; const bf16* Bt; int M, N, K, lda; };

struct StaticOrder {
    int nM, nN, nwg, G, c;
    __device__ void init(int M_, int N_, int G_, int c_) { nM = M_ / BM; nN = N_ / BM; nwg = nM * nN; G = G_; c = c_; }
    __device__ bool next(int i, Unit& u) const {
        const long L = (long)i * G + c; if (L >= nwg) return false;
        int wgid = (int)L; { const int q = nwg / NXCD, r = nwg % NXCD, xcd = wgid % NXCD, off = wgid / NXCD; wgid = (xcd < r ? xcd * (q + 1) : r * (q + 1) + (xcd - r) * q) + off; }
        const int nig = WGM * nN, gid = wgid / nig, fm = gid * WGM, gsz = (nM - fm) < WGM ? (nM - fm) : WGM;
        u.pm = fm + ((wgid % nig) % gsz); u.pn = (wgid % nig) / gsz; u.acol = 0; return true;
    }
};
struct GatesOrder {
    int G, c;
    __device__ bool next(int i, Unit& u) const { const int L = i * G + c; if (L >= 640) return false; u.pm = L / 10; u.pn = L - 10 * u.pm; u.acol = (u.pn >> 1) * 256; return true; }
};

template <class Epi, class Sched, bool ALIGN_EPI>
__device__ __forceinline__ void gemm_phase(LAS unsigned char* lds, const Gemm g, const Sched& S, const Epi& E) {
    int tid_ = threadIdx.x; asm volatile("" : "+v"(tid_));
    const int tid = tid_, wid = __builtin_amdgcn_readfirstlane(tid >> 6), lane = tid & 63, wr = wid >> 2, wc = wid & 3, fr = lane & 15, fq = lane >> 4;
    int K_ = g.K, lda_ = g.lda; asm volatile("" : "+s"(K_), "+s"(lda_));
    const int K = K_, nt = K / BK, lda = lda_;
    unsigned voffA[2], voffB[2];
#pragma unroll
    for (int i = 0; i < 2; ++i) { int R, C; stage_rc(tid * 16 + i * 8192, R, C); const int Rb = Epi::PERM ? ((R & ~31) + perm32(R & 31)) : R;
        voffA[i] = (unsigned)(R * lda + C) * 2u; voffB[i] = (unsigned)(Rb * K + C) * 2u; }
    const size_t kstep = (size_t)(BK * 2);
    const size_t hsA = (size_t)HALF * lda * 2, hsB = (size_t)HALF * K * 2;
    const size_t tsA = 2 * hsA, tsB = 2 * hsB;
    const unsigned ldsw = (unsigned)wid * 1024u;
    const int aoff = lds_byte(wr * 64 + fr, fq * 8), boff = lds_byte(wc * 32 + fr, fq * 8);
#define PG8_SA(b, h) (((b) * 2 + (h)) * HTB)
#define PG8_SB(b, h) ((4 + (b) * 2 + (h)) * HTB)
#define PG8_STAGE(bufoff, gbase, voff) do { _Pragma("unroll") for (int _i = 0; _i < 2; ++_i) \
        __builtin_amdgcn_global_load_lds((const unsigned*)((const char*)(gbase) + (voff)[_i]), (LAS unsigned*)(lds + (bufoff) + ldsw + _i * 8192), 16, 0, 0); } while (0)
#define PG8_LDA(dst, b, h) do { _Pragma("unroll") for (int m = 0; m < 4; ++m) _Pragma("unroll") for (int k = 0; k < 2; ++k) dst[m][k] = *(const LAS bf16x8*)(lds + PG8_SA(b, h) + aoff + m * 2048 + k * 1024); } while (0)
#define PG8_LDB(dst, b, h) do { _Pragma("unroll") for (int n = 0; n < 2; ++n) _Pragma("unroll") for (int k = 0; k < 2; ++k) dst[n][k] = *(const LAS bf16x8*)(lds + PG8_SB(b, h) + boff + n * 2048 + k * 1024); } while (0)
#define PG8_MMA(ai, bj, At, Bt) do { __builtin_amdgcn_s_setprio(1); _Pragma("unroll") for (int m = 0; m < 4; ++m) _Pragma("unroll") for (int n = 0; n < 2; ++n) _Pragma("unroll") for (int k = 0; k < 2; ++k) \
        acc[ai][bj][m][n] = __builtin_amdgcn_mfma_f32_16x16x32_bf16(Bt[n][k], At[m][k], acc[ai][bj][m][n], 0, 0, 0); __builtin_amdgcn_s_setprio(0); } while (0)
#define PG8_WAIT_V(n) asm volatile("s_waitcnt vmcnt(" #n ")" ::: "memory")
#define PG8_WAIT_L(n) asm volatile("s_waitcnt lgkmcnt(" #n ")" ::: "memory")
#define PG8_BAR __builtin_amdgcn_s_barrier()
#define PG8_SCHED __builtin_amdgcn_sched_barrier(0)
    Unit cur, nxt; int ui = 0;
    if (!S.next(0, cur)) return;
    f32x4 acc[2][2][4][2];
#pragma unroll
    for (int a = 0; a < 2; ++a)
#pragma unroll
        for (int b = 0; b < 2; ++b)
#pragma unroll
            for (int m = 0; m < 4; ++m)
#pragma unroll
                for (int n = 0; n < 2; ++n) acc[a][b][m][n] = (f32x4){0.f, 0.f, 0.f, 0.f};
    bf16x8 At[4][2], B0[2][2], B1[2][2];
    const char* cA = (const char*)g.A + (size_t)cur.pm * tsA + (size_t)cur.acol * 2; const char* cB = (const char*)g.Bt + (size_t)cur.pn * tsB;
    PG8_STAGE(PG8_SB(0, 0), cB, voffB); PG8_STAGE(PG8_SB(0, 1), cB + hsB, voffB); PG8_STAGE(PG8_SA(0, 0), cA, voffA); PG8_STAGE(PG8_SA(0, 1), cA + hsA, voffA);
    if (wr == 1) PG8_BAR;
    PG8_WAIT_V(2); PG8_BAR;
    PG8_STAGE(PG8_SB(1, 0), cB + kstep, voffB); PG8_STAGE(PG8_SA(1, 0), cA + kstep, voffA); PG8_STAGE(PG8_SB(1, 1), cB + hsB + kstep, voffB);
    PG8_WAIT_V(6); PG8_BAR;
    for (;;) {
        const bool has_next = S.next(ui + 1, nxt);
        const char* nA = has_next ? (const char*)g.A + (size_t)nxt.pm * tsA + (size_t)nxt.acol * 2 : cA; const char* nB = has_next ? (const char*)g.Bt + (size_t)nxt.pn * tsB : cB;
        for (int t = 0; t < nt; t += 2) {
            const bool last = (t == nt - 2);
            const char* a1 = cA + (size_t)(t + 1) * kstep;
            const char* a2 = last ? nA : cA + (size_t)(t + 2) * kstep; const char* b2 = last ? nB : cB + (size_t)(t + 2) * kstep;
            const char* a3 = a2 + kstep; const char* b3 = b2 + kstep;
            PG8_LDB(B0, 0, 0); PG8_LDB(B1, 0, 1); PG8_SCHED; PG8_LDA(At, 0, 0); PG8_STAGE(PG8_SA(1, 1), a1 + hsA, voffA);
            PG8_WAIT_V(8); PG8_WAIT_L(0); PG8_BAR; PG8_MMA(0, 0, At, B0); PG8_MMA(0, 1, At, B1); PG8_BAR; PG8_SCHED;
            PG8_LDA(At, 0, 1); PG8_STAGE(PG8_SB(0, 0), b2, voffB); PG8_STAGE(PG8_SB(0, 1), b2 + hsB, voffB); PG8_STAGE(PG8_SA(0, 0), a2, voffA);
            PG8_WAIT_V(8); PG8_WAIT_L(0); PG8_BAR; PG8_MMA(1, 0, At, B0); PG8_MMA(1, 1, At, B1); PG8_BAR; PG8_SCHED;
            PG8_LDB(B0, 1, 0); PG8_LDB(B1, 1, 1); PG8_SCHED; PG8_LDA(At, 1, 0); PG8_STAGE(PG8_SA(0, 1), a2 + hsA, voffA);
            PG8_WAIT_V(8); PG8_WAIT_L(0); PG8_BAR; PG8_MMA(0, 0, At, B0); PG8_MMA(0, 1, At, B1); PG8_BAR; PG8_SCHED;
            PG8_LDA(At, 1, 1); PG8_STAGE(PG8_SB(1, 0), b3, voffB); PG8_STAGE(PG8_SB(1, 1), b3 + hsB, voffB); PG8_STAGE(PG8_SA(1, 0), a3, voffA);
            PG8_WAIT_V(8); PG8_WAIT_L(0); PG8_BAR; PG8_MMA(1, 0, At, B0); PG8_MMA(1, 1, At, B1); PG8_BAR; PG8_SCHED;
        }
        if constexpr (ALIGN_EPI) { if (wr == 0) PG8_BAR; }
        E(acc, cur, wr, wc, fr, fq);
        if (!has_next) break;
#pragma unroll
        for (int a = 0; a < 2; ++a)
#pragma unroll
            for (int b = 0; b < 2; ++b)
#pragma unroll
                for (int m = 0; m < 4; ++m)
#pragma unroll
                    for (int n = 0; n < 2; ++n) acc[a][b][m][n] = (f32x4){0.f, 0.f, 0.f, 0.f};
        cur = nxt; cA = nA; cB = nB; ++ui;
        if constexpr (ALIGN_EPI) { if (wr == 1) PG8_BAR; }
    }
    PG8_WAIT_V(0);
    if constexpr (!ALIGN_EPI) { if (wr == 0) PG8_BAR; }
    PG8_BAR;
#undef PG8_SA
#undef PG8_SB
#undef PG8_STAGE
#undef PG8_LDA
#undef PG8_LDB
#undef PG8_MMA
#undef PG8_WAIT_V
#undef PG8_WAIT_L
#undef PG8_BAR
#undef PG8_SCHED
}

typedef f32x4 AccT[2][2][4][2];

struct EpiPlain {
    static constexpr bool PERM = true;
    bf16* O; int ldc; float scale;
    __device__ __forceinline__ void operator()(const AccT& acc, const Unit& u, int wr, int wc, int fr, int fq) const {
        const int row0 = u.pm * BM + wr * 64 + fr, col0 = u.pn * BM + wc * 32 + 8 * fq;
#pragma unroll
        for (int ai = 0; ai < 2; ++ai)
#pragma unroll
            for (int m = 0; m < 4; ++m) { bf16* rowp = O + (size_t)(row0 + ai * HALF + m * 16) * ldc + col0;
#pragma unroll
                for (int bj = 0; bj < 2; ++bj) { const f32x4 v0 = acc[ai][bj][m][0] * scale, v1 = acc[ai][bj][m][1] * scale;
                    u32x4 w; w.x = pk2(v0[0], v0[1]); w.y = pk2(v0[2], v0[3]); w.z = pk2(v1[0], v1[1]); w.w = pk2(v1[2], v1[3]);
                    *(u32x4*)(rowp + bj * HALF) = w; } }
    }
};
__device__ __forceinline__ float gelu_tanh(float v) {
    const float u2 = v * (1.5957691216057308f + 0.07135481627260025f * v * v);
    return v * frcp(1.0f + fexp2(-u2 * LOG2E));
}
struct EpiInProj {
    static constexpr bool PERM = true;
    bf16* Y; bf16* XB;
    __device__ __forceinline__ void operator()(const AccT& acc, const Unit& u, int wr, int wc, int fr, int fq) const {
        const int row0 = u.pm * BM + wr * 64 + fr; int colt = u.pn * BM; const bool isy = colt < LW; bf16* base = isy ? Y : XB; if (!isy) colt -= LW;
        const int col0 = colt + wc * 32 + 8 * fq;
#pragma unroll
        for (int ai = 0; ai < 2; ++ai)
#pragma unroll
            for (int m = 0; m < 4; ++m) { bf16* rowp = base + (size_t)(row0 + ai * HALF + m * 16) * LW + col0;
#pragma unroll
                for (int bj = 0; bj < 2; ++bj) { f32x4 v0 = acc[ai][bj][m][0], v1 = acc[ai][bj][m][1];
                    if (isy) {
#pragma unroll
                        for (int j = 0; j < 4; ++j) { v0[j] = gelu_tanh(v0[j]); v1[j] = gelu_tanh(v1[j]); } }
                    u32x4 w; w.x = pk2(v0[0], v0[1]); w.y = pk2(v0[2], v0[3]); w.z = pk2(v1[0], v1[1]); w.w = pk2(v1[2], v1[3]);
                    *(u32x4*)(rowp + bj * HALF) = w; } }
    }
};
struct EpiGates {
    static constexpr bool PERM = true;
    const bf16* XC; bf16* LA; bf16* BBo; const float* bgr; const float* bgi; const float* c8;
    __device__ __forceinline__ void operator()(const AccT& acc, const Unit& u, int wr, int wc, int fr, int fq) const {
        const int row0 = u.pm * BM + wr * 64 + fr; const int ch0 = (u.pn >> 1) * 256 + (u.pn & 1) * 128 + wc * 32 + 8 * fq;
        float br[8], bi[8], cc[8];
#pragma unroll
        for (int j = 0; j < 8; ++j) { br[j] = -LOG2E * bgr[ch0 + j]; bi[j] = -LOG2E * bgi[ch0 + j]; cc[j] = c8[ch0 + j]; }
#pragma unroll
        for (int ai = 0; ai < 2; ++ai)
#pragma unroll
            for (int m = 0; m < 4; ++m) { const size_t off = (size_t)(row0 + ai * HALF + m * 16) * LW + ch0;
                float xc[8]; unpack8(*(const u32x4*)(XC + off), xc);
                float la[8], bb[8];
#pragma unroll
                for (int n = 0; n < 2; ++n)
#pragma unroll
                    for (int j = 0; j < 4; ++j) { const int e = 4 * n + j;
                        const float r = frcp(1.0f + fexp2(acc[ai][0][m][n][j] * (-LOG2E) + br[e])), ig = frcp(1.0f + fexp2(acc[ai][1][m][n][j] * (-LOG2E) + bi[e]));
                        const float l = -cc[e] * r; const float a2 = fexp2((2.0f * LOG2E) * l);
                        la[e] = l; bb[e] = __builtin_sqrtf(1.0f - a2) * (ig * xc[e]); }
                u32x4 w; w.x = pk2(la[0], la[1]); w.y = pk2(la[2], la[3]); w.z = pk2(la[4], la[5]); w.w = pk2(la[6], la[7]);
                *(u32x4*)(LA + off) = w;
                w.x = pk2(bb[0], bb[1]); w.y = pk2(bb[2], bb[3]); w.z = pk2(bb[4], bb[5]); w.w = pk2(bb[6], bb[7]);
                *(u32x4*)(BBo + off) = w;
                asm volatile("" ::: "memory"); }
    }
};
struct EpiSwiGLU {
    static constexpr bool PERM = true;
    bf16* HF;
    __device__ __forceinline__ void operator()(const AccT& acc, const Unit& u, int wr, int wc, int fr, int fq) const {
        const int row0 = u.pm * BM + wr * 64 + fr, col0 = u.pn * HALF + wc * 32 + 8 * fq;
#pragma unroll
        for (int ai = 0; ai < 2; ++ai)
#pragma unroll
            for (int m = 0; m < 4; ++m) { float o[8];
#pragma unroll
                for (int n = 0; n < 2; ++n)
#pragma unroll
                    for (int j = 0; j < 4; ++j) { const float gt = acc[ai][0][m][n][j], up = acc[ai][1][m][n][j]; o[4 * n + j] = gt * frcp(1.0f + fexp2(-gt * LOG2E)) * up; }
                u32x4 w; w.x = pk2(o[0], o[1]); w.y = pk2(o[2], o[3]); w.z = pk2(o[4], o[5]); w.w = pk2(o[6], o[7]);
                *(u32x4*)(HF + (size_t)(row0 + ai * HALF + m * 16) * FF + col0) = w; }
    }
};
struct EpiResid {
    static constexpr bool PERM = true;
    const void* resid; void* out; const float* gv; int gstride; int rbf, obf;
    __device__ __forceinline__ void operator()(const AccT& acc, const Unit& u, int wr, int wc, int fr, int fq) const {
        const int row0 = u.pm * BM + wr * 64 + fr, col0 = u.pn * BM + wc * 32 + 8 * fq; const float* gp = gv + (size_t)(u.pm >> 5) * gstride + col0;
        f32x4 gg[2][2];
#pragma unroll
        for (int bj = 0; bj < 2; ++bj)
#pragma unroll
            for (int n = 0; n < 2; ++n) gg[bj][n] = *(const f32x4*)(gp + bj * HALF + 4 * n);
#pragma unroll
        for (int ai = 0; ai < 2; ++ai)
#pragma unroll
            for (int m = 0; m < 4; ++m) { const size_t off = (size_t)(row0 + ai * HALF + m * 16) * D + col0;
#pragma unroll
                for (int bj = 0; bj < 2; ++bj) { const size_t o = off + bj * HALF; f32x4 r0, r1;
                    if (rbf) { const u32x4 w = *(const u32x4*)((const bf16*)resid + o); r0 = (f32x4){bflo(w.x), bfhi(w.x), bflo(w.y), bfhi(w.y)}; r1 = (f32x4){bflo(w.z), bfhi(w.z), bflo(w.w), bfhi(w.w)}; }
                    else { r0 = *(const f32x4*)((const float*)resid + o); r1 = *(const f32x4*)((const float*)resid + o + 4); }
                    const f32x4 x0 = r0 + gg[bj][0] * acc[ai][bj][m][0], x1 = r1 + gg[bj][1] * acc[ai][bj][m][1];
                    if (obf) { u32x4 w; w.x = pk2(x0[0], x0[1]); w.y = pk2(x0[2], x0[3]); w.z = pk2(x1[0], x1[1]); w.w = pk2(x1[2], x1[3]); *(u32x4*)((bf16*)out + o) = w; }
                    else { *(f32x4*)((float*)out + o) = x0; *(f32x4*)((float*)out + o + 4) = x1; } } }
    }
};
}

constexpr size_t MiB = 1u << 20;
constexpr size_t WS_CTL = 0, CTL_ZERO_BYTES = 1 * MiB;
constexpr int CW_TMO = 0, CW_BAR = 4096, CW_LCNT = 16384;
constexpr size_t WS_MOD0 = 1 * MiB, WS_MOD1 = WS_MOD0 + 65536, WS_KVMOD = WS_MOD1 + 65536, WS_C8 = WS_KVMOD + 32768, WS_KM = WS_C8 + 8192;
constexpr size_t WS_SA = 250 * MiB, WS_SB = 253 * MiB;
constexpr size_t WS_ML = 5 * MiB;
constexpr size_t WS_WIN = 8 * MiB, WS_WG = 13 * MiB, WS_WOUT = 15 * MiB, WS_WKV = 18 * MiB, WS_WQ = 20 * MiB, WS_WO = 22 * MiB;
constexpr size_t WS_WGU0 = 24 * MiB, WS_WGU1 = 35 * MiB, WS_WD0 = 46 * MiB, WS_WD1 = 52 * MiB;
constexpr size_t ACT = 58 * MiB;
constexpr size_t WS_H_L0 = ACT, WS_Y = ACT + 32 * MiB, WS_XB = ACT + 72 * MiB, WS_XC = ACT + 112 * MiB, WS_BB = ACT + 152 * MiB;
constexpr size_t WS_H_F0 = ACT, WS_HF0 = ACT + 32 * MiB;
constexpr size_t WS_XS = 224 * MiB;
constexpr size_t DO_QB = 0, DO_KB = 32 * MiB, DO_VT = 48 * MiB;
constexpr size_t WS_LIST = ACT, WS_OP = ACT + 16 * MiB;
constexpr size_t WS_HKV = ACT + 16 * MiB, WS_H_L1 = ACT + 48 * MiB;
constexpr size_t WS_H_F1 = ACT + 112 * MiB, WS_HF1 = ACT;
constexpr size_t WS_END = 256 * MiB;
constexpr int LIST_CAP = 16384;

constexpr int RING_OFF = 0, RING_BYTES = 131072;
constexpr int LDSCTL_OFF = RING_BYTES, MISC_OFF = LDSCTL_OFF + 320;
constexpr int BT_OFF = LDSCTL_OFF + 512;
constexpr int PRE_OFF = BT_OFF + 4096;
constexpr int LDS_BYTES = 147456;
static_assert(PRE_OFF + 2048 <= LDS_BYTES, "LDS map");

#define RLX_AGENT __ATOMIC_RELAXED, __HIP_MEMORY_SCOPE_AGENT
#define LDS_WAIT() asm volatile("s_waitcnt lgkmcnt(0)" ::: "memory")

#define XB_TMO      128
#define XB_XCNT(j)  (256  + 64 * (j))
#define XB_XSUB(j)  (1280 + 64 * (j))
#define XB_XGEN(j)  (2304 + 64 * (j))
#define XB_TOP      3328
#define XB_TOPGEN   3392
#define XCD_BAR_WORDS 3456
#define XB_SPIN_CAP (1u << 18)
__device__ __forceinline__ unsigned xb_ld(unsigned* p)              { return __hip_atomic_load(p, __ATOMIC_RELAXED, __HIP_MEMORY_SCOPE_AGENT); }
__device__ __forceinline__ unsigned xb_add(unsigned* p, unsigned v) { return __hip_atomic_fetch_add(p, v, __ATOMIC_RELAXED, __HIP_MEMORY_SCOPE_AGENT); }
__device__ __forceinline__ unsigned xb_xcc_id() { return (unsigned)__builtin_amdgcn_s_getreg((3 << 11) | 20) & 0xFu; }
#define XB_SPIN(cond, bar) do { unsigned _sp = 0; while (cond) { __builtin_amdgcn_s_sleep(1); \
    if ((++_sp & 255u) == 0u) { if (xb_ld(&(bar)[XB_TMO])) break; if (_sp > XB_SPIN_CAP) { atomicAdd(&(bar)[XB_TMO], 1u); break; } } } } while (0)
struct XcdBarrier { unsigned* bar; unsigned x; volatile LAS unsigned* st; };
__device__ __forceinline__ XcdBarrier xcd_barrier_post(unsigned* bar, volatile LAS unsigned* st) {
    XcdBarrier b; b.bar = bar; b.x = xb_xcc_id(); b.st = st;
    if (threadIdx.x == 0) (void)xb_add(&bar[XB_XCNT(b.x)], 1u);
    return b;
}
__device__ __forceinline__ void xcd_barrier_complete(unsigned* bar, unsigned x, unsigned& nloc, unsigned& nx) {
    const unsigned G = gridDim.x * gridDim.y * gridDim.z;
    unsigned sum, cnt, mine, sp = 0u;
    for (;;) {
        sum = 0u; cnt = 0u; mine = 0u;
#pragma nounroll
        for (unsigned j = 0; j < 16; ++j) { const unsigned c = xb_ld(&bar[XB_XCNT(j)]); sum += c; cnt += (c > 0u) ? 1u : 0u; mine = (j == x) ? c : mine; }
        if (sum == G) break;
        __builtin_amdgcn_s_sleep(1);
        if ((++sp & 255u) == 0u) { if (xb_ld(&bar[XB_TMO])) break; if (sp > XB_SPIN_CAP) { atomicAdd(&bar[XB_TMO], 1u); break; } }
    }
    nloc = mine > 0u ? mine : 1u; nx = cnt > 0u ? cnt : 1u;
}
__device__ __forceinline__ void xcd_barrier(const XcdBarrier& b) {
    asm volatile("s_waitcnt vmcnt(0)" ::: "memory");
    __syncthreads();
    int tid0_ = threadIdx.x; asm volatile("" : "+v"(tid0_));
    if (tid0_ == 0) {
        unsigned* bar = b.bar;
        __builtin_amdgcn_s_waitcnt(0);
        unsigned nloc = b.st[0], nx = b.st[1];
        if (nloc == 0u) { xcd_barrier_complete(bar, b.x, nloc, nx); b.st[0] = nloc; b.st[1] = nx; }
        const unsigned old = xb_add(&bar[XB_XSUB(b.x)], 1u);
        const unsigned gen = old / nloc;
        if (old + 1u == (gen + 1u) * nloc) {
            __builtin_amdgcn_fence(__ATOMIC_RELEASE, "agent");
            asm volatile("s_waitcnt vmcnt(0)" ::: "memory");
            const unsigned og = xb_add(&bar[XB_TOP], 1u);
            const unsigned tg = og / nx;
            if (og + 1u == (tg + 1u) * nx) xb_add(&bar[XB_TOPGEN], 1u);
            else XB_SPIN(xb_ld(&bar[XB_TOPGEN]) == tg, bar);
            __builtin_amdgcn_fence(__ATOMIC_ACQUIRE, "agent");
            xb_add(&bar[XB_XGEN(b.x)], 1u);
            asm volatile("s_waitcnt vmcnt(0)" ::: "memory");
        } else {
            XB_SPIN(xb_ld(&bar[XB_XGEN(b.x)]) == gen, bar);
            __builtin_amdgcn_fence(__ATOMIC_ACQUIRE, "agent");
            asm volatile("s_waitcnt vmcnt(0)" ::: "memory");
        }
    }
    __syncthreads();
}

struct Args { const float* in[24]; float* out; unsigned char* ws; int ph_lo, ph_hi; };
static_assert(offsetof(Args, out) == 192 && offsetof(Args, ws) == 200, "kernarg layout");
struct Frame {
    LAS unsigned char* lds;
    int tid, lane, wave, G, bid, dry;
    const __attribute__((address_space(4))) unsigned char* kp; float* out; unsigned char* ws;
};
#define CAS __attribute__((address_space(4)))
#define ARG_IN(F, i) (((const float* const CAS*)(F).kp)[(i)])
enum { I_X = 0, I_C, I_MODW, I_MODB, I_NMIX, I_NFFN, I_WIN, I_CONVW, I_CONVB, I_WGATES, I_BGATES, I_LAMBDA, I_WOUT, I_KVMODW, I_KVMODB, I_KVNORM, I_WKV, I_WQ, I_WO, I_RELB, I_FGATE, I_FUP, I_FDOWN, I_FNORM };

__device__ __forceinline__ void fresh_ids(Frame& F) {
    int t = threadIdx.x; asm volatile("" : "+v"(t)); F.tid = t; F.lane = t & 63; F.wave = __builtin_amdgcn_readfirstlane(t >> 6);
    const CAS unsigned char* kp = (const CAS unsigned char*)__builtin_amdgcn_kernarg_segment_ptr(); asm volatile("" : "+s"(kp)); F.kp = kp;
    F.out = *(float* const CAS*)(kp + 192); F.ws = *(unsigned char* const CAS*)(kp + 200);
    int g = gridDim.x; asm volatile("" : "+s"(g)); F.G = g;
    int bx = blockIdx.x; asm volatile("" : "+s"(bx)); F.bid = bx;
}
__device__ __forceinline__ float wave_sum(float v) {
#pragma unroll
    for (int o = 1; o < 64; o <<= 1) v += __shfl_xor(v, o);
    return v;
}

__device__ __forceinline__ void p_modgemv(Frame& F) {
    LAS float* cs = (LAS float*)(F.lds + RING_OFF);
    LAS float* red = cs + 2048;
    for (int i = F.tid; i < 2048; i += 512) { const float c = ARG_IN(F, I_C)[i]; cs[i] = c * frcp(1.0f + fexp2(-c * LOG2E)); }
    __syncthreads();
    for (int it = F.bid; it < 224; it += F.G) {
        const float* W; const float* bias; float* out; int N, g;
        if (it < 96) { W = ARG_IN(F, I_MODW); N = 6 * D; g = it; bias = ARG_IN(F, I_MODB); out = (float*)(F.ws + WS_MOD0); }
        else if (it < 192) { W = ARG_IN(F, I_MODW) + (size_t)D * 6 * D; N = 6 * D; g = it - 96; bias = ARG_IN(F, I_MODB) + 6 * D; out = (float*)(F.ws + WS_MOD1); }
        else { W = ARG_IN(F, I_KVMODW); N = 2 * D; g = it - 192; bias = ARG_IN(F, I_KVMODB); out = (float*)(F.ws + WS_KVMOD); }
        const int col = g * 64 + F.lane; const int k0 = 128 * F.wave;
        const float* wp = W + (size_t)k0 * N + col;
        float a0 = 0.f, a1 = 0.f;
#pragma unroll 16
        for (int j = 0; j < 128; ++j) { const float w = wp[(size_t)j * N]; a0 += cs[k0 + j] * w; a1 += cs[1024 + k0 + j] * w; }
        red[(F.wave * 2 + 0) * 64 + F.lane] = a0; red[(F.wave * 2 + 1) * 64 + F.lane] = a1;
        __syncthreads();
        if (F.tid < 128) { const int b = F.tid >> 6, l = F.tid & 63; float s = 0.f;
#pragma unroll
            for (int w = 0; w < 8; ++w) s += red[(w * 2 + b) * 64 + l];
            out[(size_t)b * N + g * 64 + l] = s + bias[g * 64 + l]; }
        __syncthreads();
    }
}
struct TItem { const float* src; bf16* dst; int N, K, k0, n0, drow0; };
__device__ __forceinline__ void ti_load(const TItem& t, float (&wv)[32], int lane) {
#pragma unroll
    for (int i = 0; i < 32; ++i) wv[i] = t.src[(size_t)(t.k0 + 2 * i + (lane >> 5)) * t.N + t.n0 + (lane & 31)];
}
__device__ __forceinline__ void ti_store(const TItem& t, const float (&wv)[32], LAS float* scr, int lane) {
#pragma unroll
    for (int i = 0; i < 32; ++i) scr[(2 * i + (lane >> 5)) * 33 + (lane & 31)] = wv[i];
    LDS_WAIT(); asm volatile("" ::: "memory");
    const int c = lane & 7;
#pragma unroll
    for (int j = 0; j < 4; ++j) { const int n = (lane >> 3) + 8 * j; const LAS float* q = scr + (8 * c) * 33 + n;
        u32x4 o; o.x = pk2(q[0 * 33], q[1 * 33]); o.y = pk2(q[2 * 33], q[3 * 33]); o.z = pk2(q[4 * 33], q[5 * 33]); o.w = pk2(q[6 * 33], q[7 * 33]);
        *(GAS u32x4*)(t.dst + (size_t)(t.drow0 + n) * t.K + t.k0 + 8 * c) = o; }
    LDS_WAIT(); asm volatile("" ::: "memory");
}
__device__ __forceinline__ TItem ti_get(Frame& F, int stage, int r) {
    unsigned char* ws = F.ws; TItem t;
    constexpr int I_IN = (D / 64) * (2 * LW / 32), I_G = LH * (LB / 64) * (2 * LB / 32), I_SQ = (D / 64) * (D / 32), I_FU = (D / 64) * (FF / 32);
    if (stage == 0) {
        if (r < I_IN) { const int nb = 2 * LW / 32; t = TItem{ARG_IN(F, I_WIN), (bf16*)(ws + WS_WIN), 2 * LW, D, 64 * (r / nb), 32 * (r % nb), 32 * (r % nb)}; return t; } r -= I_IN;
        if (r < I_G) { const int h = r / 64, rr = r % 64, n0 = 32 * (rr % 16);
            t = TItem{ARG_IN(F, I_WGATES) + (size_t)h * LB * 2 * LB, (bf16*)(ws + WS_WG), 2 * LB, LB, 64 * (rr / 16), n0, (2 * h + ((n0 % 256) / 128)) * 256 + 128 * (n0 / 256) + (n0 % 128)}; return t; } r -= I_G;
        { const int nb = D / 32; t = TItem{ARG_IN(F, I_WOUT), (bf16*)(ws + WS_WOUT), D, LW, 64 * (r / nb), 32 * (r % nb), 32 * (r % nb)}; return t; }
    }
    const int l = stage - 1;
    if (stage == 2) {
        if (r < 3 * I_SQ) { const int w = r / I_SQ, rr = r % I_SQ, nb = D / 32;
            t = TItem{w == 0 ? ARG_IN(F, I_WKV) : (w == 1 ? ARG_IN(F, I_WQ) : ARG_IN(F, I_WO)), (bf16*)(ws + (w == 0 ? WS_WKV : (w == 1 ? WS_WQ : WS_WO))), D, D, 64 * (rr / nb), 32 * (rr % nb), 32 * (rr % nb)}; return t; } r -= 3 * I_SQ;
    }
    if (r < 2 * I_FU) { const int up = r / I_FU, rr = r % I_FU, nb = FF / 32, n0 = 32 * (rr % nb);
        t = TItem{(up ? ARG_IN(F, I_FUP) : ARG_IN(F, I_FGATE)) + (size_t)l * D * FF, (bf16*)(ws + (l ? WS_WGU1 : WS_WGU0)), FF, D, 64 * (rr / nb), n0, 256 * (n0 / 128) + 128 * up + (n0 % 128)}; return t; } r -= 2 * I_FU;
    { const int nb = D / 32; t = TItem{ARG_IN(F, I_FDOWN) + (size_t)l * FF * D, (bf16*)(ws + (l ? WS_WD1 : WS_WD0)), D, FF, 64 * (r / nb), 32 * (r % nb), 32 * (r % nb)}; return t; }
}
__device__ __forceinline__ void p_weights(Frame& F, int stage, int gw, int NGW) {
    LAS float* scr = (LAS float*)(F.lds + RING_OFF + 16384 + F.wave * 12288);
    constexpr int I_IN = (D / 64) * (2 * LW / 32), I_G = LH * (LB / 64) * (2 * LB / 32), I_OUT = (LW / 64) * (D / 32), I_SQ = (D / 64) * (D / 32), I_FU = (D / 64) * (FF / 32), I_FD = (FF / 64) * (D / 32);
    const int nitems = stage == 0 ? I_IN + I_G + I_OUT : (stage == 1 ? 2 * I_FU + I_FD : 3 * I_SQ + 2 * I_FU + I_FD);
    if (stage == 0)
        for (int i = F.bid * 512 + F.tid; i < LW; i += F.G * 512) { const float x = -ARG_IN(F, I_LAMBDA)[i]; const float sp = fmaxf(x, 0.f) + log1pf(__expf(-fabsf(x))); ((float*)(F.ws + WS_C8))[i] = 8.0f * sp; }
    int it = gw; if (it >= nitems) return;
    float va[32], vb[32];
    TItem ta = ti_get(F, stage, it), tb = ta; ti_load(ta, va, F.lane);
    for (;;) {
        const int it2 = it + NGW; const bool m2 = it2 < nitems;
        if (m2) { tb = ti_get(F, stage, it2); ti_load(tb, vb, F.lane); }
        ti_store(ta, va, scr, F.lane);
        if (!m2) break;
        const int it3 = it2 + NGW; const bool m3 = it3 < nitems;
        if (m3) { ta = ti_get(F, stage, it3); ti_load(ta, va, F.lane); }
        ti_store(tb, vb, scr, F.lane);
        if (!m3) break;
        it = it3;
    }
}
__device__ __forceinline__ void p_weights_bubble(Frame& F, int stage) {
    const int G = F.G, rounds = (640 + G - 1) / G, full = 640 - (rounds - 1) * G;
    if (F.dry) return;
    if (full < G) { if (F.bid >= full) p_weights(F, stage, (F.bid - full) * 8 + F.wave, (G - full) * 8); }
    else p_weights(F, stage, F.bid * 8 + F.wave, G * 8);
}
template <int NOUT, bool XBF>
__device__ __forceinline__ void norm_mod_rows(Frame& F, const void* X, const float* g0, const float* sh0, const float* sc0, int bs0, bf16* o0,
                                              const float* g1, const float* sh1, const float* sc1, int bs1, bf16* o1) {
    const int gw = F.bid * 8 + F.wave, NGW = F.G * 8;
    for (int b = 0; b < BATCH; ++b) {
        f32x4 gs0[4], sv0[4], gs1[4], sv1[4];
#pragma unroll
        for (int j = 0; j < 4; ++j) { const int c = 8 * (F.lane + 64 * (j >> 1)) + 4 * (j & 1);
            const f32x4 g = *(const f32x4*)(g0 + c), sc = *(const f32x4*)(sc0 + (size_t)b * bs0 + c); gs0[j] = g * (sc + 1.0f); sv0[j] = *(const f32x4*)(sh0 + (size_t)b * bs0 + c);
            if (NOUT == 2) { const f32x4 gB = *(const f32x4*)(g1 + c), scB = *(const f32x4*)(sc1 + (size_t)b * bs1 + c); gs1[j] = gB * (scB + 1.0f); sv1[j] = *(const f32x4*)(sh1 + (size_t)b * bs1 + c); } }
        u32x4 rawb[2]; f32x4 rawf[4];
        auto load_row = [&](int m) {
            if constexpr (XBF) { const u32x4* xr = (const u32x4*)((const bf16*)X + (size_t)m * D) + F.lane; rawb[0] = xr[0]; rawb[1] = xr[64]; }
            else { const f32x4* xr = (const f32x4*)((const float*)X + (size_t)m * D) + 2 * F.lane; rawf[0] = xr[0]; rawf[1] = xr[1]; rawf[2] = xr[128]; rawf[3] = xr[129]; } };
        int m = b * SEQ + gw; const int mend = (b + 1) * SEQ;
        if (m < mend) load_row(m);
        for (; m < mend; m += NGW) {
            f32x4 v[4]; float s = 0.f;
            if constexpr (XBF) {
#pragma unroll
                for (int jj = 0; jj < 2; ++jj) { const u32x4 w = rawb[jj]; v[2 * jj] = (f32x4){bflo(w.x), bfhi(w.x), bflo(w.y), bfhi(w.y)}; v[2 * jj + 1] = (f32x4){bflo(w.z), bfhi(w.z), bflo(w.w), bfhi(w.w)}; }
            } else {
#pragma unroll
                for (int j = 0; j < 4; ++j) v[j] = rawf[j]; }
            if (m + NGW < mend) load_row(m + NGW);
#pragma unroll
            for (int j = 0; j < 4; ++j) s += (v[j].x * v[j].x + v[j].y * v[j].y) + (v[j].z * v[j].z + v[j].w * v[j].w);
            const float rstd = 1.0f / sqrtf(wave_sum(s) * (1.0f / D) + RMS_EPS);
            u32x4* p0 = (u32x4*)(o0 + (size_t)m * D) + F.lane;
#pragma unroll
            for (int jj = 0; jj < 2; ++jj) { const f32x4 y0 = v[2 * jj] * rstd * gs0[2 * jj] + sv0[2 * jj], y1 = v[2 * jj + 1] * rstd * gs0[2 * jj + 1] + sv0[2 * jj + 1];
                u32x4 w; w.x = pk2(y0.x, y0.y); w.y = pk2(y0.z, y0.w); w.z = pk2(y1.x, y1.y); w.w = pk2(y1.z, y1.w); p0[64 * jj] = w; }
            if (NOUT == 2) { u32x4* p1 = (u32x4*)(o1 + (size_t)m * D) + F.lane;
#pragma unroll
                for (int jj = 0; jj < 2; ++jj) { const f32x4 y0 = v[2 * jj] * rstd * gs1[2 * jj] + sv1[2 * jj], y1 = v[2 * jj + 1] * rstd * gs1[2 * jj + 1] + sv1[2 * jj + 1];
                    u32x4 w; w.x = pk2(y0.x, y0.y); w.y = pk2(y0.z, y0.w); w.z = pk2(y1.x, y1.y); w.w = pk2(y1.z, y1.w); p1[64 * jj] = w; } }
        }
    }
}
__device__ __forceinline__ void final_norm_rows(Frame& F, const float* X, float* O, const float* g) {
    const int gw = F.bid * 8 + F.wave, NGW = F.G * 8;
    f32x4 gg[4];
#pragma unroll
    for (int j = 0; j < 4; ++j) gg[j] = *(const f32x4*)(g + 4 * (F.lane + 64 * j));
    f32x4 nx[4];
    int m = gw;
    if (m < M) { const f32x4* xr = (const f32x4*)(X + (size_t)m * D) + F.lane;
#pragma unroll
        for (int j = 0; j < 4; ++j) nx[j] = xr[64 * j]; }
    for (; m < M; m += NGW) {
        f32x4 v[4]; float s = 0.f;
#pragma unroll
        for (int j = 0; j < 4; ++j) v[j] = nx[j];
        if (m + NGW < M) { const f32x4* xr = (const f32x4*)(X + (size_t)(m + NGW) * D) + F.lane;
#pragma unroll
            for (int j = 0; j < 4; ++j) nx[j] = xr[64 * j]; }
#pragma unroll
        for (int j = 0; j < 4; ++j) s += (v[j].x * v[j].x + v[j].y * v[j].y) + (v[j].z * v[j].z + v[j].w * v[j].w);
        const float rstd = 1.0f / sqrtf(wave_sum(s) * (1.0f / D) + RMS_EPS);
        f32x4* orow = (f32x4*)(O + (size_t)m * D) + F.lane;
#pragma unroll
        for (int j = 0; j < 4; ++j) orow[64 * j] = v[j] * rstd * gg[j];
    }
}

__device__ __forceinline__ void p_conv(Frame& F) {
    const bf16* XB = (const bf16*)(F.ws + WS_XB); bf16* XC = (bf16*)(F.ws + WS_XC);
    const float* cw = ARG_IN(F, I_CONVW); const float* cb = ARG_IN(F, I_CONVB);
    const int NT = F.G * 512;
    for (int gid = F.bid * 512 + F.tid; gid < (M / 32) * (LW / 8); gid += NT) {
        const int cg = gid % (LW / 8), chunk = gid / (LW / 8), ch = cg * 8, m0 = chunk * 32;
        float w0[8], w1[8], w2[8], w3[8], bb[8];
#pragma unroll
        for (int e = 0; e < 8; ++e) { w0[e] = cw[ch + e]; w1[e] = cw[LW + ch + e]; w2[e] = cw[2 * LW + ch + e]; w3[e] = cw[3 * LW + ch + e]; bb[e] = cb[ch + e]; }
        float x3[8], x2[8], x1[8], x0[8];
        if ((m0 % SEQ) == 0) {
#pragma unroll
            for (int e = 0; e < 8; ++e) { x3[e] = 0.f; x2[e] = 0.f; x1[e] = 0.f; }
        } else {
            unpack8(*(const u32x4*)(XB + (size_t)(m0 - 3) * LW + ch), x3); unpack8(*(const u32x4*)(XB + (size_t)(m0 - 2) * LW + ch), x2); unpack8(*(const u32x4*)(XB + (size_t)(m0 - 1) * LW + ch), x1);
        }
#pragma unroll 4
        for (int r = 0; r < 32; ++r) {
            unpack8(*(const u32x4*)(XB + (size_t)(m0 + r) * LW + ch), x0);
            float o[8];
#pragma unroll
            for (int e = 0; e < 8; ++e) { o[e] = bb[e] + w0[e] * x3[e] + w1[e] * x2[e] + w2[e] * x1[e] + w3[e] * x0[e]; x3[e] = x2[e]; x2[e] = x1[e]; x1[e] = x0[e]; }
            u32x4 w; w.x = pk2(o[0], o[1]); w.y = pk2(o[2], o[3]); w.z = pk2(o[4], o[5]); w.w = pk2(o[6], o[7]);
            *(u32x4*)(XC + (size_t)(m0 + r) * LW + ch) = w;
        }
    }
}
constexpr int SCH = 32, NCH = SEQ / SCH, CG = LW / 8;
__device__ __forceinline__ void p_scan1(Frame& F) {
    const u32x4* LA = (const u32x4*)(F.ws + WS_XB); const u32x4* BB = (const u32x4*)(F.ws + WS_BB);
    float* SA = (float*)(F.ws + WS_SA); float* SB = (float*)(F.ws + WS_SB);
    const int NT = F.G * 512;
    for (int gid = F.bid * 512 + F.tid; gid < BATCH * NCH * CG; gid += NT) {
        const int g = gid % CG, bc = gid / CG;
        const u32x4* la = LA + (size_t)bc * SCH * CG + g; const u32x4* bb = BB + (size_t)bc * SCH * CG + g;
        float h[8], sm[8];
#pragma unroll
        for (int e = 0; e < 8; ++e) { h[e] = 0.f; sm[e] = 0.f; }
#pragma unroll 1
        for (int r0 = 0; r0 < SCH; r0 += 16) {
            u32x4 lv[16], bv[16];
#pragma unroll
            for (int r = 0; r < 16; ++r) { lv[r] = la[(size_t)(r0 + r) * CG]; bv[r] = bb[(size_t)(r0 + r) * CG]; }
#pragma unroll
            for (int r = 0; r < 16; ++r) { float l[8], u[8]; unpack8(lv[r], l); unpack8(bv[r], u);
#pragma unroll
                for (int e = 0; e < 8; ++e) { h[e] = fexp2(l[e] * LOG2E) * h[e] + u[e]; sm[e] += l[e]; } }
        }
        f32x4* sa = (f32x4*)(SA + (size_t)bc * LW + 8 * g); f32x4* sb = (f32x4*)(SB + (size_t)bc * LW + 8 * g);
        sa[0] = (f32x4){fexp2(sm[0] * LOG2E), fexp2(sm[1] * LOG2E), fexp2(sm[2] * LOG2E), fexp2(sm[3] * LOG2E)};
        sa[1] = (f32x4){fexp2(sm[4] * LOG2E), fexp2(sm[5] * LOG2E), fexp2(sm[6] * LOG2E), fexp2(sm[7] * LOG2E)};
        sb[0] = (f32x4){h[0], h[1], h[2], h[3]}; sb[1] = (f32x4){h[4], h[5], h[6], h[7]};
    }
}
__device__ __forceinline__ void p_scan_carry(Frame& F) {
    const float* SA = (const float*)(F.ws + WS_SA); float* SB = (float*)(F.ws + WS_SB);
    LAS float* segA = (LAS float*)(F.lds + RING_OFF); LAS float* segB = segA + 512;
    const int seg = F.tid >> 5, cl = F.tid & 31;
    for (int it = F.bid; it < BATCH * (LW / 32); it += F.G) {
        const int b = it / (LW / 32), ch = (it % (LW / 32)) * 32 + cl;
        const size_t base = (size_t)(b * NCH + 16 * seg) * LW + ch;
        float a[16], bq[16];
#pragma unroll
        for (int j = 0; j < 16; ++j) { a[j] = SA[base + (size_t)j * LW]; bq[j] = SB[base + (size_t)j * LW]; }
        float A = 1.f, B = 0.f;
#pragma unroll
        for (int j = 0; j < 16; ++j) { B = a[j] * B + bq[j]; A *= a[j]; }
        segA[seg * 32 + cl] = A; segB[seg * 32 + cl] = B;
        __syncthreads();
        float H = 0.f;
        for (int s2 = 0; s2 < seg; ++s2) H = segA[s2 * 32 + cl] * H + segB[s2 * 32 + cl];
#pragma unroll
        for (int j = 0; j < 16; ++j) { SB[base + (size_t)j * LW] = H; H = a[j] * H + bq[j]; }
        __syncthreads();
    }
}
__device__ __forceinline__ void p_scan2(Frame& F) {
    const u32x4* LA = (const u32x4*)(F.ws + WS_XB); const u32x4* BB = (const u32x4*)(F.ws + WS_BB);
    u32x4* Y = (u32x4*)(F.ws + WS_Y); u32x4* YO = F.dry ? (u32x4*)(F.ws + WS_XC) : Y;
    const float* SB = (const float*)(F.ws + WS_SB);
    const int NT = F.G * 512;
    for (int gid = F.bid * 512 + F.tid; gid < BATCH * NCH * CG; gid += NT) {
        const int g = gid % CG, bc = gid / CG;
        const size_t base = (size_t)bc * SCH * CG + g;
        float h[8];
        { const f32x4 c0 = *(const f32x4*)(SB + (size_t)bc * LW + 8 * g), c1 = *(const f32x4*)(SB + (size_t)bc * LW + 8 * g + 4);
          h[0] = c0.x; h[1] = c0.y; h[2] = c0.z; h[3] = c0.w; h[4] = c1.x; h[5] = c1.y; h[6] = c1.z; h[7] = c1.w; }
#pragma unroll 1
        for (int r0 = 0; r0 < SCH; r0 += 8) {
            u32x4 lv[8], bv[8], yv[8];
#pragma unroll
            for (int r = 0; r < 8; ++r) { const size_t o = base + (size_t)(r0 + r) * CG; lv[r] = LA[o]; bv[r] = BB[o]; yv[r] = Y[o]; }
#pragma unroll
            for (int r = 0; r < 8; ++r) { float l[8], u[8], y[8]; unpack8(lv[r], l); unpack8(bv[r], u); unpack8(yv[r], y);
#pragma unroll
                for (int e = 0; e < 8; ++e) h[e] = fexp2(l[e] * LOG2E) * h[e] + u[e];
                u32x4 w; w.x = pk2(h[0] * y[0], h[1] * y[1]); w.y = pk2(h[2] * y[2], h[3] * y[3]); w.z = pk2(h[4] * y[4], h[5] * y[5]); w.w = pk2(h[6] * y[6], h[7] * y[7]);
                YO[base + (size_t)(r0 + r) * CG] = w; }
        }
    }
}

__device__ __forceinline__ void p_kmean(Frame& F) {
    if (F.dry && DRY_VARIANT == 5) return;
    const bf16* KB = (const bf16*)((unsigned char*)F.out + DO_KB); float* KM = (float*)(F.ws + WS_KM);
    LAS float* red = (LAS float*)(F.lds + RING_OFF);
    const int dg = F.lane & 15, rg = F.wave * 4 + (F.lane >> 4);
    for (int it = F.bid; it < BATCH * NKV * NB; it += F.G) {
        const int n = it % NB, kvh = (it / NB) % NKV, b = it / (NB * NKV);
        const u32x4* kp = (const u32x4*)(KB + (size_t)(b * SEQ + n * BLK + rg * 8) * (NKV * HD) + kvh * HD) + dg;
        float sm[8];
#pragma unroll
        for (int e = 0; e < 8; ++e) sm[e] = 0.f;
        u32x4 kv[8];
#pragma unroll
        for (int r = 0; r < 8; ++r) kv[r] = kp[(size_t)r * (NKV * HD / 8)];
#pragma unroll
        for (int r = 0; r < 8; ++r) { float x[8]; unpack8(kv[r], x);
#pragma unroll
            for (int e = 0; e < 8; ++e) sm[e] += x[e]; }
#pragma unroll
        for (int e = 0; e < 8; ++e) red[rg * 128 + 8 * dg + e] = sm[e];
        __syncthreads();
        if (F.tid < 128) { float t = 0.f;
#pragma unroll
            for (int w = 0; w < 32; ++w) t += red[w * 128 + F.tid];
            KM[(size_t)it * HD + F.tid] = t * (1.0f / BLK); }
        __syncthreads();
    }
}
#define MFMA32(a, b, c) __builtin_amdgcn_mfma_f32_32x32x16_bf16((a), (b), (c), 0, 0, 0)
__device__ __forceinline__ void top3_insert(float g, int n, float& v0, float& v1, float& v2, int& i0, int& i1, int& i2) {
    const bool c0 = g > v0, c1 = g > v1, c2 = g > v2;
    const float nv2 = c1 ? v1 : (c2 ? g : v2); const int ni2 = c1 ? i1 : (c2 ? n : i2);
    const float nv1 = c0 ? v0 : (c1 ? g : v1); const int ni1 = c0 ? i0 : (c1 ? n : i1);
    v0 = c0 ? g : v0; i0 = c0 ? n : i0; v1 = nv1; i1 = ni1; v2 = nv2; i2 = ni2;
}
__device__ __forceinline__ void gate_group(const bf16* QB, const bf16x8 (&kh)[8], const bf16x8 (&kl)[8], LAS int* cntl, int b, int tg, int h, int kvh, int li, int hi, int own,
                                           int& s0, int& s1, int& s2, int& p0, int& p1, int& p2) {
    const int t = tg + li;
    const bf16* qp = QB + (size_t)(b * SEQ + t) * D + h * HD + 8 * hi;
    f32x16 acc;
#pragma unroll
    for (int r = 0; r < 16; ++r) acc[r] = 0.f;
#pragma unroll
    for (int ks = 0; ks < 8; ++ks) { const bf16x8 qf = *(const bf16x8*)(qp + 16 * ks); acc = MFMA32(kh[ks], qf, acc); acc = MFMA32(kl[ks], qf, acc); }
    int i0 = -1, i1 = -1, i2 = -1; float v0 = -3.0e38f, v1 = -3.0e38f, v2 = -3.0e38f;
#pragma unroll
    for (int r = 0; r < 16; ++r) { const int n = (r & 3) + 8 * (r >> 2) + 4 * hi; top3_insert(n < own ? acc[r] : -3.0e38f, n, v0, v1, v2, i0, i1, i2); }
    const float w0 = __shfl_xor(v0, 32), w1 = __shfl_xor(v1, 32), w2 = __shfl_xor(v2, 32);
    const int j0 = __shfl_xor(i0, 32), j1 = __shfl_xor(i1, 32), j2 = __shfl_xor(i2, 32);
    top3_insert(j0 >= 0 ? w0 : -3.0e38f, j0, v0, v1, v2, i0, i1, i2);
    top3_insert(j1 >= 0 ? w1 : -3.0e38f, j1, v0, v1, v2, i0, i1, i2);
    top3_insert(j2 >= 0 ? w2 : -3.0e38f, j2, v0, v1, v2, i0, i1, i2);
    s0 = i0; s1 = i1; s2 = i2; p0 = 0; p1 = 0; p2 = 0;
    if (hi == 0) {
        if (i0 >= 0) p0 = __hip_atomic_fetch_add(&cntl[kvh * NB + i0], 1, __ATOMIC_RELAXED, __HIP_MEMORY_SCOPE_WORKGROUP);
        if (i1 >= 0) p1 = __hip_atomic_fetch_add(&cntl[kvh * NB + i1], 1, __ATOMIC_RELAXED, __HIP_MEMORY_SCOPE_WORKGROUP);
        if (i2 >= 0) p2 = __hip_atomic_fetch_add(&cntl[kvh * NB + i2], 1, __ATOMIC_RELAXED, __HIP_MEMORY_SCOPE_WORKGROUP);
    }
}
__device__ __forceinline__ void p_gate(Frame& F) {
    const bf16* QB = (const bf16*)((unsigned char*)F.out + DO_QB); const float* KM = (const float*)(F.ws + WS_KM);
    unsigned* LIST = (unsigned*)(F.ws + (F.dry ? WS_OP : WS_LIST)); unsigned* gcnt = (unsigned*)(F.ws + WS_CTL) + CW_LCNT + (F.dry ? 256 : 0);
    LAS int* cntl = (LAS int*)(F.lds + RING_OFF);
    const int h = F.wave, kvh = h >> 1, li = F.lane & 31, hi = F.lane >> 5;
    for (int tile = F.bid; tile < M / 64; tile += F.G) {
        const int b = tile / (SEQ / 64), t0 = (tile % (SEQ / 64)) * 64, own = t0 / BLK;
        if (F.tid < 256) cntl[F.tid] = 0;
        __syncthreads();
        bf16x8 kh[8], kl[8];
        { const float* kmp = KM + ((size_t)((b * NKV + kvh) * NB + li)) * HD + 8 * hi;
#pragma unroll
          for (int ks = 0; ks < 8; ++ks) { const f32x4 a = *(const f32x4*)(kmp + 16 * ks), c = *(const f32x4*)(kmp + 16 * ks + 4);
              u32x4 wh; wh.x = pk2(a.x, a.y); wh.y = pk2(a.z, a.w); wh.z = pk2(c.x, c.y); wh.w = pk2(c.z, c.w);
              u32x4 wl; wl.x = pk2(a.x - bflo(wh.x), a.y - bfhi(wh.x)); wl.y = pk2(a.z - bflo(wh.y), a.w - bfhi(wh.y)); wl.z = pk2(c.x - bflo(wh.z), c.y - bfhi(wh.z)); wl.w = pk2(c.z - bflo(wh.w), c.w - bfhi(wh.w));
              kh[ks] = __builtin_bit_cast(bf16x8, wh); kl[ks] = __builtin_bit_cast(bf16x8, wl); } }
        int sa0, sa1, sa2, pa0, pa1, pa2, sb0, sb1, sb2, pb0, pb1, pb2;
        gate_group(QB, kh, kl, cntl, b, t0, h, kvh, li, hi, own, sa0, sa1, sa2, pa0, pa1, pa2);
        gate_group(QB, kh, kl, cntl, b, t0 + 32, h, kvh, li, hi, own, sb0, sb1, sb2, pb0, pb1, pb2);
        __syncthreads();
        if (F.tid < 128) { const int c = cntl[F.tid]; int base = 0; if (c > 0) base = (int)atomicAdd(&gcnt[b * 128 + F.tid], (unsigned)c); cntl[128 + F.tid] = base; }
        __syncthreads();
        if (hi == 0) {
            const size_t lb = (size_t)(b * 128 + kvh * NB); const int cb = 128 + kvh * NB;
            const unsigned ea = ((unsigned)(t0 + li) << 3) | ((unsigned)(h & 1) << 2), eb = ((unsigned)(t0 + 32 + li) << 3) | ((unsigned)(h & 1) << 2);
            if (sa0 >= 0) LIST[(lb + sa0) * LIST_CAP + cntl[cb + sa0] + pa0] = ea | 0u;
            if (sa1 >= 0) LIST[(lb + sa1) * LIST_CAP + cntl[cb + sa1] + pa1] = ea | 1u;
            if (sa2 >= 0) LIST[(lb + sa2) * LIST_CAP + cntl[cb + sa2] + pa2] = ea | 2u;
            if (sb0 >= 0) LIST[(lb + sb0) * LIST_CAP + cntl[cb + sb0] + pb0] = eb | 0u;
            if (sb1 >= 0) LIST[(lb + sb1) * LIST_CAP + cntl[cb + sb1] + pb1] = eb | 1u;
            if (sb2 >= 0) LIST[(lb + sb2) * LIST_CAP + cntl[cb + sb2] + pb2] = eb | 2u;
        }
        __syncthreads();
    }
}

constexpr int HBUF = 65536;
__device__ __forceinline__ void build_bias_table(Frame& F) {
    LAS float* BT = (LAS float*)(F.lds + BT_OFF);
    for (int i = F.tid; i < NH * 128; i += 512) { const int h = i >> 7, d = i & 127; int bk;
        if (d < 16) bk = d; else { bk = 16 + (int)(logf((float)d / 16.0f) / 2.0794415416798357f * 16.0f); bk = bk < 31 ? bk : 31; }
        BT[i] = ARG_IN(F, I_RELB)[h * 32 + bk] * LOG2E; }
}
__device__ __forceinline__ void glds_half(Frame& F, int b, int kvh, int n, int half, int buf) {
    int ln = F.lane; asm volatile("" : "+v"(ln));
    const int wv = F.wave;
    const char* kb = (const char*)((const bf16*)((unsigned char*)F.out + DO_KB) + (size_t)(b * SEQ + n * BLK + half * 128 + 16 * wv) * (NKV * HD) + kvh * HD);
    const char* vb = (const char*)((const bf16*)((unsigned char*)F.out + DO_VT) + (size_t)(kvh * HD + 16 * wv) * M + b * SEQ + n * BLK + half * 128);
    const int r4 = ln >> 4, slot = ln & 15;
#pragma unroll
    for (int i = 0; i < 4; ++i) { const int rr = 4 * i + r4; const unsigned ko = (unsigned)(rr * (NKV * HD) * 2 + ((slot ^ rr) << 4));
        __builtin_amdgcn_global_load_lds((const unsigned*)(kb + ko), (LAS unsigned*)(F.lds + RING_OFF + buf * HBUF + (wv * 4 + i) * 1024), 16, 0, 0); }
#pragma unroll
    for (int i = 0; i < 4; ++i) { const int rr = 4 * i + r4; const unsigned vo = (unsigned)rr * (unsigned)(M * 2) + (unsigned)((slot ^ rr) << 4);
        __builtin_amdgcn_global_load_lds((const unsigned*)(vb + vo), (LAS unsigned*)(F.lds + RING_OFF + buf * HBUF + 32768 + (wv * 4 + i) * 1024), 16, 0, 0); }
}
#define ATT_WAIT_BAR() do { asm volatile("s_waitcnt vmcnt(0) lgkmcnt(0)" ::: "memory"); __builtin_amdgcn_s_barrier(); asm volatile("" ::: "memory"); } while (0)
struct AttState { f32x16 o[4]; float m, l; };
template <int MODE>
__device__ __forceinline__ void attn_tile(Frame& F, AttState& st, const bf16x8 (&qf)[8], const int kbase, const int vbase, int kt, int qpos, int hbase, float cb) {
    const int hi = F.lane >> 5;
    const LAS float* BT = (const LAS float*)(F.lds + BT_OFF) + hbase;
    const LAS unsigned char* hb = F.lds + RING_OFF + (kt >> 1) * HBUF;
    const int kl = kt & 1;
    f32x16 s[2];
#pragma unroll
    for (int sub = 0; sub < 2; ++sub) {
        f32x16 a;
#pragma unroll
        for (int r = 0; r < 16; ++r) a[r] = 0.f;
#pragma unroll
        for (int ks = 0; ks < 8; ++ks) { const bf16x8 kf = *(const LAS bf16x8*)(hb + (kbase ^ (ks << 5)) + (64 * kl + 32 * sub) * 256); a = MFMA32(kf, qf[ks], a); }
        s[sub] = a;
    }
    float mx = -1.0e30f;
#pragma unroll
    for (int sub = 0; sub < 2; ++sub)
#pragma unroll
        for (int r = 0; r < 16; ++r) { const int key = 64 * kt + 32 * sub + (r & 7) + 8 * hi + 16 * (r >> 3);
            float v = s[sub][r];
            if (MODE == 0) v += cb;
            else { const int dist = qpos - key; const int idx = dist < 0 ? 0 : (dist > 127 ? 127 : dist); v += BT[idx]; if (MODE == 2 && dist < 0) v = -1.0e30f; }
            s[sub][r] = v; mx = fmaxf(mx, v); }
    mx = fmaxf(mx, __shfl_xor(mx, 32));
    if (__any(mx > st.m)) {
        const float mnew = fmaxf(st.m, mx), alpha = fexp2(st.m - mnew);
        st.m = mnew; st.l *= alpha;
#pragma unroll
        for (int db = 0; db < 4; ++db) st.o[db] = st.o[db] * alpha;
    }
    const float mcur = st.m;
    float ls = 0.f;
#pragma unroll
    for (int sub = 0; sub < 2; ++sub) {
        bf16x8 pf[2];
#pragma unroll
        for (int sh = 0; sh < 2; ++sh) { float p[8];
#pragma unroll
            for (int j = 0; j < 8; ++j) { p[j] = fexp2(s[sub][8 * sh + j] - mcur); ls += p[j]; }
            u32x4 w; w.x = pk2(p[0], p[1]); w.y = pk2(p[2], p[3]); w.z = pk2(p[4], p[5]); w.w = pk2(p[6], p[7]);
            pf[sh] = __builtin_bit_cast(bf16x8, w); }
#pragma unroll
        for (int db = 0; db < 4; ++db)
#pragma unroll
            for (int sh = 0; sh < 2; ++sh) { const bf16x8 vf = *(const LAS bf16x8*)(hb + 32768 + (vbase ^ ((kl * 4 + sub * 2 + sh) << 5)) + db * 32 * 256);
                st.o[db] = MFMA32(vf, pf[sh], st.o[db]); }
    }
    st.l += ls;
}
__device__ __forceinline__ void attn_lane_offsets(int lane, int& kbase, int& vbase) {
    const int i = lane & 31, hi = lane >> 5;
    const int pi = (i & ~12) | ((i & 8) >> 1) | ((i & 4) << 1);
    kbase = pi * 256 + (((hi ^ pi) & 15) << 4);
    vbase = i * 256 + (((hi ^ i) & 15) << 4);
}
__device__ __forceinline__ void attn_init(AttState& st) {
#pragma unroll
    for (int db = 0; db < 4; ++db)
#pragma unroll
        for (int r = 0; r < 16; ++r) st.o[db][r] = 0.f;
    st.m = -1.0e30f; st.l = 0.f;
}
__device__ __forceinline__ void store_row16(const f32x16 (&o)[4], float scale, bf16* rowp, int hi) {
#pragma unroll
    for (int db = 0; db < 4; ++db)
#pragma unroll
        for (int g = 0; g < 4; g += 2) {
            unsigned a0 = pk2(o[db][4 * g] * scale, o[db][4 * g + 1] * scale), a1 = pk2(o[db][4 * g + 2] * scale, o[db][4 * g + 3] * scale);
            unsigned b0 = pk2(o[db][4 * g + 4] * scale, o[db][4 * g + 5] * scale), b1 = pk2(o[db][4 * g + 6] * scale, o[db][4 * g + 7] * scale);
            const auto r0 = __builtin_amdgcn_permlane32_swap(a0, b0, false, false); const auto r1 = __builtin_amdgcn_permlane32_swap(a1, b1, false, false);
            u32x4 w; w.x = r0[0]; w.y = r1[0]; w.z = r0[1]; w.w = r1[1];
            *(u32x4*)(rowp + 32 * db + 8 * (g + hi)) = w; }
}
__device__ __forceinline__ void addrow16(f32x16 (&o)[4], float cs, const bf16* rowp, int hi) {
#pragma unroll
    for (int db = 0; db < 4; ++db)
#pragma unroll
        for (int g = 0; g < 4; g += 2) {
            const u32x4 w = *(const u32x4*)(rowp + 32 * db + 8 * (g + hi));
            const auto r0 = __builtin_amdgcn_permlane32_swap(w.x, w.z, false, false); const auto r1 = __builtin_amdgcn_permlane32_swap(w.y, w.w, false, false);
            o[db][4 * g] += cs * bflo(r0[0]); o[db][4 * g + 1] += cs * bfhi(r0[0]); o[db][4 * g + 2] += cs * bflo(r1[0]); o[db][4 * g + 3] += cs * bfhi(r1[0]);
            o[db][4 * g + 4] += cs * bflo(r0[1]); o[db][4 * g + 5] += cs * bfhi(r0[1]); o[db][4 * g + 6] += cs * bflo(r1[1]); o[db][4 * g + 7] += cs * bfhi(r1[1]); }
}
__device__ __forceinline__ unsigned pk4_fp8(float a, float b, float c, float d) { unsigned w = 0; w = __builtin_amdgcn_cvt_pk_fp8_f32(a, b, w, false); w = __builtin_amdgcn_cvt_pk_fp8_f32(c, d, w, true); return w; }
__device__ __forceinline__ void store_row_fp8(const f32x16 (&o)[4], float scale, unsigned char* rowp, int hi) {
#pragma unroll
    for (int db = 0; db < 4; ++db) {
        unsigned W[4];
#pragma unroll
        for (int g = 0; g < 4; ++g) W[g] = pk4_fp8(o[db][4 * g] * scale, o[db][4 * g + 1] * scale, o[db][4 * g + 2] * scale, o[db][4 * g + 3] * scale);
        const auto r0 = __builtin_amdgcn_permlane32_swap(W[0], W[2], false, false);
        const auto r1 = __builtin_amdgcn_permlane32_swap(W[1], W[3], false, false);
        u32x4 w; w.x = r0[0]; w.y = r0[1]; w.z = r1[0]; w.w = r1[1];
        *(u32x4*)(rowp + 32 * db + 16 * hi) = w; }
}
__device__ __forceinline__ void addrow_fp8(f32x16 (&o)[4], float cs, const unsigned char* rowp, int hi) {
#pragma unroll
    for (int db = 0; db < 4; ++db) {
        const u32x4 x = *(const u32x4*)(rowp + 32 * db + 16 * hi);
        const auto r0 = __builtin_amdgcn_permlane32_swap(x.x, x.y, false, false);
        const auto r1 = __builtin_amdgcn_permlane32_swap(x.z, x.w, false, false);
        const unsigned G[4] = {r0[0], r1[0], r0[1], r1[1]};
#pragma unroll
        for (int g = 0; g < 4; ++g) { o[db][4 * g] += cs * __builtin_amdgcn_cvt_f32_fp8(G[g], 0); o[db][4 * g + 1] += cs * __builtin_amdgcn_cvt_f32_fp8(G[g], 1);
            o[db][4 * g + 2] += cs * __builtin_amdgcn_cvt_f32_fp8(G[g], 2); o[db][4 * g + 3] += cs * __builtin_amdgcn_cvt_f32_fp8(G[g], 3); } }
}
__device__ __forceinline__ int find_list(const LAS int* pre, int item) {
    int lo = 0, hi = 256;
#pragma unroll
    for (int it = 0; it < 8; ++it) { const int mid = (lo + hi) >> 1; if (pre[mid] <= item) lo = mid; else hi = mid; }
    return __builtin_amdgcn_readfirstlane(lo);
}

__device__ __forceinline__ void p_attn_sparse(Frame& F) {
    const bf16* QB = (const bf16*)((unsigned char*)F.out + DO_QB); const unsigned* LIST = (const unsigned*)(F.ws + WS_LIST);
    unsigned* gcnt = (unsigned*)(F.ws + WS_CTL) + CW_LCNT;
    bf16* OP = (bf16*)(F.ws + WS_OP); f32x2* ML = (f32x2*)(F.ws + WS_ML);
    LAS int* pre = (LAS int*)(F.lds + PRE_OFF);
    LAS int* cnts = pre + 264;
    build_bias_table(F);
    if (F.tid < 256) { const int c = (int)__hip_atomic_load(gcnt + F.tid, RLX_AGENT); cnts[F.tid] = c; pre[F.tid + 1] = (c + 255) >> 8; }
    __syncthreads();
    if (F.tid == 0) { int s = 0; pre[0] = 0; for (int i = 1; i <= 256; ++i) { s += pre[i]; pre[i] = s; } }
    __syncthreads();
    const int total = (F.dry && DRY_VARIANT == 3) ? 0 : pre[256];
    int kbase, vbase; attn_lane_offsets(F.lane, kbase, vbase);
    const int hi = F.lane >> 5;
    int item = F.bid;
    int l = 0;
    unsigned ent = 0; bf16x8 qf[8]; bool valid = false;
#define SPARSE_FETCH_ENT(l_, item_) do { const int chunk_ = (item_) - pre[l_]; const int cnt_ = cnts[l_]; const int ri_ = chunk_ * 256 + F.wave * 32 + (F.lane & 31); \
        ent = LIST[(size_t)(l_) * LIST_CAP + (ri_ < cnt_ ? ri_ : cnt_ - 1)]; } while (0)
#define SPARSE_FETCH_Q(l_) do { const int t_ = (int)(ent >> 3), h_ = 2 * (((l_) >> 5) & 3) + (int)((ent >> 2) & 1u); const unsigned mrow_ = (unsigned)(((l_) >> 7) * SEQ + t_); \
        _Pragma("unroll") for (int ks = 0; ks < 8; ++ks) qf[ks] = *(const bf16x8*)(QB + (mrow_ * D + h_ * HD + 16 * ks + 8 * hi)); } while (0)
    if (item < total) { l = find_list(pre, item); glds_half(F, l >> 7, (l >> 5) & 3, l & 31, 0, 0); SPARSE_FETCH_ENT(l, item); SPARSE_FETCH_Q(l); ATT_WAIT_BAR(); }
    while (item < total) {
        const int b = l >> 7, kvh = (l >> 5) & 3, n = l & 31;
        const int t = (int)(ent >> 3), h = 2 * kvh + (int)((ent >> 2) & 1u), slot = (int)(ent & 3u);
        const unsigned mrow = (unsigned)(b * SEQ + t);
        glds_half(F, b, kvh, n, 1, 1);
        AttState st; attn_init(st);
        const int qpos = t - n * BLK;
        const LAS float* BT = (const LAS float*)(F.lds + BT_OFF);
        const float cb = BT[h * 128 + 127];
        const bool far = __all(qpos - 255 >= 127);
        if (far) {
#pragma unroll 1
            for (int kt = 0; kt < 2; ++kt) attn_tile<0>(F, st, qf, kbase, vbase, kt, qpos, h * 128, cb);
        } else {
#pragma unroll 1
            for (int kt = 0; kt < 2; ++kt) attn_tile<1>(F, st, qf, kbase, vbase, kt, qpos, h * 128, cb);
        }
        ATT_WAIT_BAR();
        const int item2 = item + F.G; int l2 = 0; const bool more = item2 < total;
        if (more) { l2 = find_list(pre, item2); glds_half(F, l2 >> 7, (l2 >> 5) & 3, l2 & 31, 0, 0); SPARSE_FETCH_ENT(l2, item2); }
        if (far) {
#pragma unroll 1
            for (int kt = 2; kt < 4; ++kt) attn_tile<0>(F, st, qf, kbase, vbase, kt, qpos, h * 128, cb);
        } else {
#pragma unroll 1
            for (int kt = 2; kt < 4; ++kt) attn_tile<1>(F, st, qf, kbase, vbase, kt, qpos, h * 128, cb);
        }
        if (more) { SPARSE_FETCH_Q(l2); }
        asm volatile("s_waitcnt vmcnt(8)" ::: "memory");
        __builtin_amdgcn_s_barrier(); asm volatile("" ::: "memory");
        const float lt = st.l + __shfl_xor(st.l, 32); const float inv = 1.0f / lt;
        {
            const unsigned prow = (mrow * NH + h) * 3 + slot;
            store_row_fp8(st.o, inv, (unsigned char*)OP + (size_t)prow * HD, hi);
            if (hi == 0) ML[prow] = (f32x2){st.m, lt};
        }
        item = item2; l = l2;
    }
#undef SPARSE_FETCH_ENT
#undef SPARSE_FETCH_Q
    ATT_WAIT_BAR();
}
__device__ __forceinline__ void p_attn_own(Frame& F) {
    const bf16* QB = (const bf16*)((unsigned char*)F.out + DO_QB); bf16* OB = (bf16*)((unsigned char*)F.out + DO_QB);
    const bf16* OP = (const bf16*)(F.ws + WS_OP); const f32x2* ML = (const f32x2*)(F.ws + WS_ML);
    build_bias_table(F);
    int kbase, vbase; attn_lane_offsets(F.lane, kbase, vbase);
    const int hi = F.lane >> 5;
    for (int item = F.bid; item < BATCH * NKV * NB; item += F.G) {
        const int kvh = item % NKV, j = (item / NKV) % NB, b = item / (NKV * NB);
        glds_half(F, b, kvh, j, 0, 0); glds_half(F, b, kvh, j, 1, 1);
        ATT_WAIT_BAR();
#pragma unroll 1
        for (int task = 0; task < 2; ++task) {
            const int h = 2 * kvh + task, qg = task ? 7 - F.wave : F.wave;
            const int qpos = qg * 32 + (F.lane & 31), t = j * BLK + qpos;
            const unsigned mrow = (unsigned)(b * SEQ + t);
            bf16x8 qf[8];
#pragma unroll
            for (int ks = 0; ks < 8; ++ks) qf[ks] = *(const bf16x8*)(QB + (mrow * D + h * HD + 16 * ks + 8 * hi));
            AttState st; attn_init(st);
            const int ntile = (qg >> 1) + 1;
#pragma unroll 1
            for (int kt = 0; kt < ntile; ++kt) attn_tile<2>(F, st, qf, kbase, vbase, kt, qpos, h * 128, 0.f);
            const float lo = st.l + __shfl_xor(st.l, 32);
            const int nvalid = j < 3 ? j : 3;
            const unsigned prow = (mrow * NH + h) * 3;
            f32x2 ml[3]; float mxx = st.m;
#pragma unroll
            for (int s = 0; s < 3; ++s) { ml[s] = (f32x2){-1.0e30f, 0.f}; if (s < nvalid) { ml[s] = ML[prow + s]; mxx = fmaxf(mxx, ml[s].x); } }
            const float co = fexp2(st.m - mxx); float den = co * lo;
#pragma unroll
            for (int db = 0; db < 4; ++db) st.o[db] = st.o[db] * co;
#pragma unroll
            for (int s = 0; s < 3; ++s) if (s < nvalid) { const float cs = ml[s].y * fexp2(ml[s].x - mxx); den += cs;
                addrow_fp8(st.o, cs, (const unsigned char*)OP + (size_t)(prow + s) * HD, hi); }
            const float inv = 1.0f / den;
            bf16* ob = F.dry ? (bf16*)(F.ws + WS_LIST) + ((mrow & 8191u) * D + h * HD) : OB + (mrow * D + h * HD);
            store_row16(st.o, inv, ob, hi);
        }
        ATT_WAIT_BAR();
    }
}

__global__ void __launch_bounds__(512, 2) yoco_fwd(Args args) {
    extern __shared__ __attribute__((aligned(16))) unsigned char lds_raw[];
    Frame F;
    F.lds = (LAS unsigned char*)lds_raw;
    F.tid = threadIdx.x; F.lane = F.tid & 63; F.wave = __builtin_amdgcn_readfirstlane(F.tid >> 6); F.G = gridDim.x;
    F.out = args.out; F.ws = args.ws; F.kp = (const CAS unsigned char*)__builtin_amdgcn_kernarg_segment_ptr();
    unsigned char* ws = args.ws;
    for (int u = F.tid; u < (LDS_BYTES - LDSCTL_OFF) / 4; u += 512) ((LAS unsigned*)(F.lds + LDSCTL_OFF))[u] = 0u;
    __syncthreads();
    volatile LAS unsigned* MISC = (volatile LAS unsigned*)(F.lds + MISC_OFF);
    XcdBarrier bar; bar.bar = (unsigned*)(ws + WS_CTL) + CW_BAR; bar.x = 0; bar.st = nullptr;
    const int lo = args.ph_lo, hi = args.ph_hi;
    if (hi - lo > 1) bar = xcd_barrier_post((unsigned*)(ws + WS_CTL) + CW_BAR, MISC + 8);
#ifndef PHASE_MASK
#define PHASE_MASK 0xffffffffu
#endif
#define EN(k) (((PHASE_MASK) >> (k)) & 1u)
    for (int pid = lo; pid < hi; ++pid) {
      const int nrep = 1 + (int)((REPEAT_SET >> pid) & 1u);
      for (int rep = 0; rep < nrep; ++rep) {
        fresh_ids(F); ws = F.ws; F.dry = rep;
        const int cid = F.bid;
        float* MOD0 = (float*)(ws + WS_MOD0); float* MOD1 = (float*)(ws + WS_MOD1); float* KVMOD = (float*)(ws + WS_KVMOD);
        switch (pid) {
        case 0: if (EN(0)) { p_modgemv(F); } break;
        case 1: if (EN(1)) { p_weights(F, 0, F.bid * 8 + F.wave, F.G * 8); norm_mod_rows<1, false>(F, ARG_IN(F, I_X), ARG_IN(F, I_NMIX), MOD0, MOD0 + D, 6 * D, (bf16*)(ws + WS_H_L0), nullptr, nullptr, nullptr, 0, nullptr); } break;
        case 2: if (EN(2)) { pg8::Gemm g{(const bf16*)(ws + WS_H_L0), (const bf16*)(ws + WS_WIN), M, 2 * LW, D, D}; pg8::StaticOrder S; S.init(M, 2 * LW, F.G, cid);
                pg8::EpiInProj E{(bf16*)(ws + WS_Y), (bf16*)(ws + WS_XB)};
                pg8::gemm_phase<pg8::EpiInProj, pg8::StaticOrder, true>(F.lds + RING_OFF, g, S, E); p_weights_bubble(F, 1); } break;
        case 3: if (EN(3)) p_conv(F); break;
        case 4: if (EN(4)) { pg8::Gemm g{(const bf16*)(ws + WS_XC), (const bf16*)(ws + WS_WG), M, 2 * LW, LB, LW}; pg8::GatesOrder S{F.G, cid};
                pg8::EpiGates E{(const bf16*)(ws + WS_XC), (bf16*)(ws + WS_XB), (bf16*)(ws + WS_BB), ARG_IN(F, I_BGATES), ARG_IN(F, I_BGATES) + LW, (const float*)(ws + WS_C8)};
                pg8::gemm_phase<pg8::EpiGates, pg8::GatesOrder, true>(F.lds + RING_OFF, g, S, E); p_weights_bubble(F, 2); } break;
        case 5: if (EN(5)) p_scan1(F); break;
        case 6: if (EN(6)) p_scan_carry(F); break;
        case 7: if (EN(6)) p_scan2(F); break;
        case 8: case 18: if (EN(7)) { const int layer = pid == 18; float* MOD = layer ? MOD1 : MOD0;
                pg8::Gemm g; pg8::EpiResid E; pg8::StaticOrder S; S.init(M, D, F.G, cid);
                if (layer == 0) { g = pg8::Gemm{(const bf16*)(ws + WS_Y), (const bf16*)(ws + WS_WOUT), M, D, LW, LW}; E = pg8::EpiResid{ARG_IN(F, I_X), ws + WS_XS, MOD + 2 * D, 6 * D, 0, 1}; }
                else { g = pg8::Gemm{(const bf16*)((unsigned char*)F.out + DO_QB), (const bf16*)(ws + WS_WO), M, D, D, D}; E = pg8::EpiResid{ws + WS_XS, ws + WS_XS, MOD + 2 * D, 6 * D, 1, 1}; }
                pg8::gemm_phase<pg8::EpiResid, pg8::StaticOrder, true>(F.lds + RING_OFF, g, S, E); } break;
        case 9: case 19: if (EN(8)) { const int layer = pid == 19; float* MOD = layer ? MOD1 : MOD0;
                norm_mod_rows<1, true>(F, ws + WS_XS, ARG_IN(F, I_NFFN) + layer * D, MOD + 3 * D, MOD + 4 * D, 6 * D, (bf16*)(ws + (layer ? WS_H_F1 : WS_H_F0)), nullptr, nullptr, nullptr, 0, nullptr); } break;
        case 10: case 20: if (EN(9)) { const int layer = pid == 20;
                pg8::Gemm g{(const bf16*)(ws + (layer ? WS_H_F1 : WS_H_F0)), (const bf16*)(ws + (layer ? WS_WGU1 : WS_WGU0)), M, 2 * FF, D, D}; pg8::StaticOrder S; S.init(M, 2 * FF, F.G, cid);
                pg8::EpiSwiGLU E{(bf16*)(ws + (layer ? WS_HF1 : WS_HF0))};
                pg8::gemm_phase<pg8::EpiSwiGLU, pg8::StaticOrder, true>(F.lds + RING_OFF, g, S, E); } break;
        case 11: case 21: if (EN(10)) { const int layer = pid == 21; float* MOD = layer ? MOD1 : MOD0;
                pg8::Gemm g{(const bf16*)(ws + (layer ? WS_HF1 : WS_HF0)), (const bf16*)(ws + (layer ? WS_WD1 : WS_WD0)), M, D, FF, FF}; pg8::StaticOrder S; S.init(M, D, F.G, cid);
                pg8::EpiResid E{ws + WS_XS, layer ? (void*)F.out : (void*)(ws + WS_XS), MOD + 5 * D, 6 * D, 1, layer ? 0 : 1};
                pg8::gemm_phase<pg8::EpiResid, pg8::StaticOrder, true>(F.lds + RING_OFF, g, S, E); } break;
        case 12: if (EN(11)) norm_mod_rows<2, true>(F, ws + WS_XS, ARG_IN(F, I_KVNORM), KVMOD, KVMOD + D, 2 * D, (bf16*)(ws + WS_HKV), ARG_IN(F, I_NMIX) + D, MOD1, MOD1 + D, 6 * D, (bf16*)(ws + WS_H_L1)); break;
        case 13: if (EN(12)) {
                for (int g3 = 0; g3 < 3; ++g3) {
                    pg8::Gemm g; pg8::EpiPlain E; pg8::StaticOrder S;
                    if (g3 == 0) { g = pg8::Gemm{(const bf16*)(ws + WS_HKV), (const bf16*)(ws + WS_WKV), M, NKV * HD, D, D}; E = pg8::EpiPlain{(bf16*)((unsigned char*)F.out + DO_KB), NKV * HD, 1.0f}; S.init(M, NKV * HD, F.G, cid); }
                    else if (g3 == 1) { g = pg8::Gemm{(const bf16*)(ws + WS_WKV) + (size_t)(NKV * HD) * D, (const bf16*)(ws + WS_HKV), NKV * HD, M, D, D}; E = pg8::EpiPlain{(bf16*)((unsigned char*)F.out + DO_VT), M, 1.0f};
                        S.init(NKV * HD, M, F.G, F.G >= 256 ? (cid + 128) % F.G : cid); }
                    else { g = pg8::Gemm{(const bf16*)(ws + WS_H_L1), (const bf16*)(ws + WS_WQ), M, D, D, D}; E = pg8::EpiPlain{(bf16*)((unsigned char*)F.out + DO_QB), D, 0.08838834764831845f * LOG2E}; S.init(M, D, F.G, cid); }
                    pg8::gemm_phase<pg8::EpiPlain, pg8::StaticOrder, true>(F.lds + RING_OFF, g, S, E);
                } } break;
        case 14: if (EN(13)) p_kmean(F); break;
        case 15: if (EN(14)) p_gate(F); break;
        case 16: if (EN(15)) p_attn_sparse(F); break;
        case 17: if (EN(16)) p_attn_own(F); break;
        default: if (EN(22)) final_norm_rows(F, F.out, F.dry ? (float*)(ws + ACT) : F.out, ARG_IN(F, I_FNORM)); break;
        }
        if (pid + 1 < hi || rep + 1 < nrep) { bar.bar = (unsigned*)(ws + WS_CTL) + CW_BAR; xcd_barrier(bar); }
      }
    }
}
constexpr int N_PHASES = 23;

extern "C" void kernel_launch(void* const* d_in, const int* in_sizes, int n_in, void* d_out, int out_size, void* d_ws, size_t ws_size, hipStream_t stream) {
    static int grid = 0;
    if (grid == 0) {
        if (n_in != 24 || out_size != M * D || ws_size < WS_END) { fprintf(stderr, "kernel_launch: unexpected shapes (n_in %d out %d ws %zu)\n", n_in, out_size, ws_size); grid = -1; return; }
        int dev = 0, cus = 0;
        if (hipGetDevice(&dev) != hipSuccess || hipDeviceGetAttribute(&cus, hipDeviceAttributeMultiprocessorCount, dev) != hipSuccess) { grid = -1; return; }
        if (hipFuncSetAttribute((const void*)yoco_fwd, hipFuncAttributeMaxDynamicSharedMemorySize, LDS_BYTES) != hipSuccess) { fprintf(stderr, "kernel_launch: hipFuncSetAttribute failed\n"); grid = -1; return; }
        (void)hipGetLastError();
        grid = cus;
    }
    if (grid < 0) return;
    if (hipMemsetAsync((char*)d_ws + WS_CTL, 0, CTL_ZERO_BYTES, stream) != hipSuccess) return;
    Args a{};
    for (int i = 0; i < 24; ++i) a.in[i] = (const float*)d_in[i];
    a.out = (float*)d_out; a.ws = (unsigned char*)d_ws;
#if MK_N_LAUNCHES == 1
    a.ph_lo = 0; a.ph_hi = N_PHASES;
    hipLaunchKernelGGL(yoco_fwd, dim3(grid), dim3(512), LDS_BYTES, stream, a);
#else
    for (int p = 0; p < N_PHASES; ++p) { a.ph_lo = p; a.ph_hi = p + 1; hipLaunchKernelGGL(yoco_fwd, dim3(grid), dim3(512), LDS_BYTES, stream, a); }
#endif
}
```

```cpp
#include <hip/hip_runtime.h>
#include <cstdio>
#include <cstdint>
#include <cstddef>

#ifndef MK_N_LAUNCHES
#define MK_N_LAUNCHES 1
#endif

#define DRY_VARIANT 2
#define REPEAT_SET 0x0u
#define GAS __attribute__((address_space(1)))
#define LAS __attribute__((address_space(3)))
typedef unsigned short bf16;
typedef short bf16x8 __attribute__((ext_vector_type(8)));
typedef float f32x2 __attribute__((ext_vector_type(2)));
typedef float f32x4 __attribute__((ext_vector_type(4)));
typedef float f32x16 __attribute__((ext_vector_type(16)));
typedef unsigned u32x2 __attribute__((ext_vector_type(2)));
typedef unsigned u32x4 __attribute__((ext_vector_type(4)));
typedef __bf16 bf16x2_t __attribute__((ext_vector_type(2)));
typedef GAS unsigned gu32;

__device__ __forceinline__ unsigned pk2(float lo, float hi) { f32x2 v = {lo, hi}; return __builtin_bit_cast(unsigned, __builtin_convertvector(v, bf16x2_t)); }
__device__ __forceinline__ float bflo(unsigned u) { return __uint_as_float(u << 16); }
__device__ __forceinline__ float bfhi(unsigned u) { return __uint_as_float(u & 0xffff0000u); }
__device__ __forceinline__ void unpack8(const u32x4 v, float (&x)[8]) { x[0] = bflo(v.x); x[1] = bfhi(v.x); x[2] = bflo(v.y); x[3] = bfhi(v.y); x[4] = bflo(v.z); x[5] = bfhi(v.z); x[6] = bflo(v.w); x[7] = bfhi(v.w); }
__device__ __forceinline__ float fexp2(float x) { return __builtin_amdgcn_exp2f(x); }
__device__ __forceinline__ float frcp(float x) { return __builtin_amdgcn_rcpf(x); }
#define LOG2E 1.4426950408889634f

constexpr int BATCH = 2, SEQ = 8192, D = 1024, M = BATCH * SEQ;
constexpr int LW = 1280, LH = 5, LB = 256;
constexpr int FF = 2816;
constexpr int NH = 8, NKV = 4, HD = 128, BLK = 256, NB = SEQ / BLK;
constexpr float RMS_EPS = 1e-6f;

namespace pg8 {
constexpr int BM = 256, BK = 64, HALF = 128, HTB = HALF * BK * 2, STAGE_BYTES = 8 * HTB, NXCD = 8, WGM = 8;
__host__ __device__ __forceinline__ int lds_byte(int r, int c) { const int st = (r >> 4) * 2 + (c >> 5), rr = r & 15, cc = c & 31, ob = rr * 64 + cc * 2; return st * 1024 + (ob ^ (((ob >> 9) & 1) << 5)); }
__host__ __device__ __forceinline__ void stage_rc(int b, int& R, int& C) { const int st = b / 1024, sb = b % 1024, swz = sb ^ (((sb >> 9) & 1) << 5); R = (st >> 1) * 16 + swz / 64; C = (st & 1) * 32 + (swz % 64) / 2; }
__host__ __device__ __forceinline__ int perm32(int rho) { const int n = rho >> 4, i = rho & 15; return 8 * (i >> 2) + 4 * n + (i & 3); }

struct Unit { int pm, pn, acol; };
struct Gemm { const bf16* A; const bf16* Bt; int M, N, K, lda; };

struct StaticOrder {
    int nM, nN, nwg, G, c;
    __device__ void init(int M_, int N_, int G_, int c_) { nM = M_ / BM; nN = N_ / BM; nwg = nM * nN; G = G_; c = c_; }
    __device__ bool next(int i, Unit& u) const {
        const long L = (long)i * G + c; if (L >= nwg) return false;
        int wgid = (int)L; { const int q = nwg / NXCD, r = nwg % NXCD, xcd = wgid % NXCD, off = wgid / NXCD; wgid = (xcd < r ? xcd * (q + 1) : r * (q + 1) + (xcd - r) * q) + off; }
        const int nig = WGM * nN, gid = wgid / nig, fm = gid * WGM, gsz = (nM - fm) < WGM ? (nM - fm) : WGM;
        u.pm = fm + ((wgid % nig) % gsz); u.pn = (wgid % nig) / gsz; u.acol = 0; return true;
    }
};
struct GatesOrder {
    int G, c;
    __device__ bool next(int i, Unit& u) const { const int L = i * G + c; if (L >= 640) return false; u.pm = L / 10; u.pn = L - 10 * u.pm; u.acol = (u.pn >> 1) * 256; return true; }
};

template <class Epi, class Sched, bool ALIGN_EPI>
__device__ __forceinline__ void gemm_phase(LAS unsigned char* lds, const Gemm g, const Sched& S, const Epi& E) {
    int tid_ = threadIdx.x; asm volatile("" : "+v"(tid_));
    const int tid = tid_, wid = __builtin_amdgcn_readfirstlane(tid >> 6), lane = tid & 63, wr = wid >> 2, wc = wid & 3, fr = lane & 15, fq = lane >> 4;
    int K_ = g.K, lda_ = g.lda; asm volatile("" : "+s"(K_), "+s"(lda_));
    const int K = K_, nt = K / BK, lda = lda_;
    unsigned voffA[2], voffB[2];
#pragma unroll
    for (int i = 0; i < 2; ++i) { int R, C; stage_rc(tid * 16 + i * 8192, R, C); const int Rb = Epi::PERM ? ((R & ~31) + perm32(R & 31)) : R;
        voffA[i] = (unsigned)(R * lda + C) * 2u; voffB[i] = (unsigned)(Rb * K + C) * 2u; }
    const size_t kstep = (size_t)(BK * 2);
    const size_t hsA = (size_t)HALF * lda * 2, hsB = (size_t)HALF * K * 2;
    const size_t tsA = 2 * hsA, tsB = 2 * hsB;
    const unsigned ldsw = (unsigned)wid * 1024u;
    const int aoff = lds_byte(wr * 64 + fr, fq * 8), boff = lds_byte(wc * 32 + fr, fq * 8);
#define PG8_SA(b, h) (((b) * 2 + (h)) * HTB)
#define PG8_SB(b, h) ((4 + (b) * 2 + (h)) * HTB)
#define PG8_STAGE(bufoff, gbase, voff) do { _Pragma("unroll") for (int _i = 0; _i < 2; ++_i) \
        __builtin_amdgcn_global_load_lds((const unsigned*)((const char*)(gbase) + (voff)[_i]), (LAS unsigned*)(lds + (bufoff) + ldsw + _i * 8192), 16, 0, 0); } while (0)
#define PG8_LDA(dst, b, h) do { _Pragma("unroll") for (int m = 0; m < 4; ++m) _Pragma("unroll") for (int k = 0; k < 2; ++k) dst[m][k] = *(const LAS bf16x8*)(lds + PG8_SA(b, h) + aoff + m * 2048 + k * 1024); } while (0)
#define PG8_LDB(dst, b, h) do { _Pragma("unroll") for (int n = 0; n < 2; ++n) _Pragma("unroll") for (int k = 0; k < 2; ++k) dst[n][k] = *(const LAS bf16x8*)(lds + PG8_SB(b, h) + boff + n * 2048 + k * 1024); } while (0)
#define PG8_MMA(ai, bj, At, Bt) do { __builtin_amdgcn_s_setprio(1); _Pragma("unroll") for (int m = 0; m < 4; ++m) _Pragma("unroll") for (int n = 0; n < 2; ++n) _Pragma("unroll") for (int k = 0; k < 2; ++k) \
        acc[ai][bj][m][n] = __builtin_amdgcn_mfma_f32_16x16x32_bf16(Bt[n][k], At[m][k], acc[ai][bj][m][n], 0, 0, 0); __builtin_amdgcn_s_setprio(0); } while (0)
#define PG8_WAIT_V(n) asm volatile("s_waitcnt vmcnt(" #n ")" ::: "memory")
#define PG8_WAIT_L(n) asm volatile("s_waitcnt lgkmcnt(" #n ")" ::: "memory")
#define PG8_BAR __builtin_amdgcn_s_barrier()
#define PG8_SCHED __builtin_amdgcn_sched_barrier(0)
    Unit cur, nxt; int ui = 0;
    if (!S.next(0, cur)) return;
    f32x4 acc[2][2][4][2];
#pragma unroll
    for (int a = 0; a < 2; ++a)
#pragma unroll
        for (int b = 0; b < 2; ++b)
#pragma unroll
            for (int m = 0; m < 4; ++m)
#pragma unroll
                for (int n = 0; n < 2; ++n) acc[a][b][m][n] = (f32x4){0.f, 0.f, 0.f, 0.f};
    bf16x8 At[4][2], B0[2][2], B1[2][2];
    const char* cA = (const char*)g.A + (size_t)cur.pm * tsA + (size_t)cur.acol * 2; const char* cB = (const char*)g.Bt + (size_t)cur.pn * tsB;
    PG8_STAGE(PG8_SB(0, 0), cB, voffB); PG8_STAGE(PG8_SB(0, 1), cB + hsB, voffB); PG8_STAGE(PG8_SA(0, 0), cA, voffA); PG8_STAGE(PG8_SA(0, 1), cA + hsA, voffA);
    if (wr == 1) PG8_BAR;
    PG8_WAIT_V(2); PG8_BAR;
    PG8_STAGE(PG8_SB(1, 0), cB + kstep, voffB); PG8_STAGE(PG8_SA(1, 0), cA + kstep, voffA); PG8_STAGE(PG8_SB(1, 1), cB + hsB + kstep, voffB);
    PG8_WAIT_V(6); PG8_BAR;
    for (;;) {
        const bool has_next = S.next(ui + 1, nxt);
        const char* nA = has_next ? (const char*)g.A + (size_t)nxt.pm * tsA + (size_t)nxt.acol * 2 : cA; const char* nB = has_next ? (const char*)g.Bt + (size_t)nxt.pn * tsB : cB;
        for (int t = 0; t < nt; t += 2) {
            const bool last = (t == nt - 2);
            const char* a1 = cA + (size_t)(t + 1) * kstep;
            const char* a2 = last ? nA : cA + (size_t)(t + 2) * kstep; const char* b2 = last ? nB : cB + (size_t)(t + 2) * kstep;
            const char* a3 = a2 + kstep; const char* b3 = b2 + kstep;
            PG8_LDB(B0, 0, 0); PG8_LDB(B1, 0, 1); PG8_SCHED; PG8_LDA(At, 0, 0); PG8_STAGE(PG8_SA(1, 1), a1 + hsA, voffA);
            PG8_WAIT_V(8); PG8_WAIT_L(0); PG8_BAR; PG8_MMA(0, 0, At, B0); PG8_MMA(0, 1, At, B1); PG8_BAR; PG8_SCHED;
            PG8_LDA(At, 0, 1); PG8_STAGE(PG8_SB(0, 0), b2, voffB); PG8_STAGE(PG8_SB(0, 1), b2 + hsB, voffB); PG8_STAGE(PG8_SA(0, 0), a2, voffA);
            PG8_WAIT_V(8); PG8_WAIT_L(0); PG8_BAR; PG8_MMA(1, 0, At, B0); PG8_MMA(1, 1, At, B1); PG8_BAR; PG8_SCHED;
            PG8_LDB(B0, 1, 0); PG8_LDB(B1, 1, 1); PG8_SCHED; PG8_LDA(At, 1, 0); PG8_STAGE(PG8_SA(0, 1), a2 + hsA, voffA);
            PG8_WAIT_V(8); PG8_WAIT_L(0); PG8_BAR; PG8_MMA(0, 0, At, B0); PG8_MMA(0, 1, At, B1); PG8_BAR; PG8_SCHED;
            PG8_LDA(At, 1, 1); PG8_STAGE(PG8_SB(1, 0), b3, voffB); PG8_STAGE(PG8_SB(1, 1), b3 + hsB, voffB); PG8_STAGE(PG8_SA(1, 0), a3, voffA);
            PG8_WAIT_V(8); PG8_WAIT_L(0); PG8_BAR; PG8_MMA(1, 0, At, B0); PG8_MMA(1, 1, At, B1); PG8_BAR; PG8_SCHED;
        }
        if constexpr (ALIGN_EPI) { if (wr == 0) PG8_BAR; }
        E(acc, cur, wr, wc, fr, fq);
        if (!has_next) break;
#pragma unroll
        for (int a = 0; a < 2; ++a)
#pragma unroll
            for (int b = 0; b < 2; ++b)
#pragma unroll
                for (int m = 0; m < 4; ++m)
#pragma unroll
                    for (int n = 0; n < 2; ++n) acc[a][b][m][n] = (f32x4){0.f, 0.f, 0.f, 0.f};
        cur = nxt; cA = nA; cB = nB; ++ui;
        if constexpr (ALIGN_EPI) { if (wr == 1) PG8_BAR; }
    }
    PG8_WAIT_V(0);
    if constexpr (!ALIGN_EPI) { if (wr == 0) PG8_BAR; }
    PG8_BAR;
#undef PG8_SA
#undef PG8_SB
#undef PG8_STAGE
#undef PG8_LDA
#undef PG8_LDB
#undef PG8_MMA
#undef PG8_WAIT_V
#undef PG8_WAIT_L
#undef PG8_BAR
#undef PG8_SCHED
}

typedef f32x4 AccT[2][2][4][2];

struct EpiPlain {
    static constexpr bool PERM = true;
    bf16* O; int ldc; float scale;
    __device__ __forceinline__ void operator()(const AccT& acc, const Unit& u, int wr, int wc, int fr, int fq) const {
        const int row0 = u.pm * BM + wr * 64 + fr, col0 = u.pn * BM + wc * 32 + 8 * fq;
#pragma unroll
        for (int ai = 0; ai < 2; ++ai)
#pragma unroll
            for (int m = 0; m < 4; ++m) { bf16* rowp = O + (size_t)(row0 + ai * HALF + m * 16) * ldc + col0;
#pragma unroll
                for (int bj = 0; bj < 2; ++bj) { const f32x4 v0 = acc[ai][bj][m][0] * scale, v1 = acc[ai][bj][m][1] * scale;
                    u32x4 w; w.x = pk2(v0[0], v0[1]); w.y = pk2(v0[2], v0[3]); w.z = pk2(v1[0], v1[1]); w.w = pk2(v1[2], v1[3]);
                    *(u32x4*)(rowp + bj * HALF) = w; } }
    }
};
__device__ __forceinline__ float gelu_tanh(float v) {
    const float u2 = v * (1.5957691216057308f + 0.07135481627260025f * v * v);
    return v * frcp(1.0f + fexp2(-u2 * LOG2E));
}
struct EpiInProj {
    static constexpr bool PERM = true;
    bf16* Y; bf16* XB;
    __device__ __forceinline__ void operator()(const AccT& acc, const Unit& u, int wr, int wc, int fr, int fq) const {
        const int row0 = u.pm * BM + wr * 64 + fr; int colt = u.pn * BM; const bool isy = colt < LW; bf16* base = isy ? Y : XB; if (!isy) colt -= LW;
        const int col0 = colt + wc * 32 + 8 * fq;
#pragma unroll
        for (int ai = 0; ai < 2; ++ai)
#pragma unroll
            for (int m = 0; m < 4; ++m) { bf16* rowp = base + (size_t)(row0 + ai * HALF + m * 16) * LW + col0;
#pragma unroll
                for (int bj = 0; bj < 2; ++bj) { f32x4 v0 = acc[ai][bj][m][0], v1 = acc[ai][bj][m][1];
                    if (isy) {
#pragma unroll
                        for (int j = 0; j < 4; ++j) { v0[j] = gelu_tanh(v0[j]); v1[j] = gelu_tanh(v1[j]); } }
                    u32x4 w; w.x = pk2(v0[0], v0[1]); w.y = pk2(v0[2], v0[3]); w.z = pk2(v1[0], v1[1]); w.w = pk2(v1[2], v1[3]);
                    *(u32x4*)(rowp + bj * HALF) = w; } }
    }
};
struct EpiGates {
    static constexpr bool PERM = true;
    const bf16* XC; bf16* LA; bf16* BBo; const float* bgr; const float* bgi; const float* c8;
    __device__ __forceinline__ void operator()(const AccT& acc, const Unit& u, int wr, int wc, int fr, int fq) const {
        const int row0 = u.pm * BM + wr * 64 + fr; const int ch0 = (u.pn >> 1) * 256 + (u.pn & 1) * 128 + wc * 32 + 8 * fq;
        float br[8], bi[8], cc[8];
#pragma unroll
        for (int j = 0; j < 8; ++j) { br[j] = -LOG2E * bgr[ch0 + j]; bi[j] = -LOG2E * bgi[ch0 + j]; cc[j] = c8[ch0 + j]; }
#pragma unroll
        for (int ai = 0; ai < 2; ++ai)
#pragma unroll
            for (int m = 0; m < 4; ++m) { const size_t off = (size_t)(row0 + ai * HALF + m * 16) * LW + ch0;
                float xc[8]; unpack8(*(const u32x4*)(XC + off), xc);
                float la[8], bb[8];
#pragma unroll
                for (int n = 0; n < 2; ++n)
#pragma unroll
                    for (int j = 0; j < 4; ++j) { const int e = 4 * n + j;
                        const float r = frcp(1.0f + fexp2(acc[ai][0][m][n][j] * (-LOG2E) + br[e])), ig = frcp(1.0f + fexp2(acc[ai][1][m][n][j] * (-LOG2E) + bi[e]));
                        const float l = -cc[e] * r; const float a2 = fexp2((2.0f * LOG2E) * l);
                        la[e] = l; bb[e] = __builtin_sqrtf(1.0f - a2) * (ig * xc[e]); }
                u32x4 w; w.x = pk2(la[0], la[1]); w.y = pk2(la[2], la[3]); w.z = pk2(la[4], la[5]); w.w = pk2(la[6], la[7]);
                *(u32x4*)(LA + off) = w;
                w.x = pk2(bb[0], bb[1]); w.y = pk2(bb[2], bb[3]); w.z = pk2(bb[4], bb[5]); w.w = pk2(bb[6], bb[7]);
                *(u32x4*)(BBo + off) = w;
                asm volatile("" ::: "memory"); }
    }
};
struct EpiSwiGLU {
    static constexpr bool PERM = true;
    bf16* HF;
    __device__ __forceinline__ void operator()(const AccT& acc, const Unit& u, int wr, int wc, int fr, int fq) const {
        const int row0 = u.pm * BM + wr * 64 + fr, col0 = u.pn * HALF + wc * 32 + 8 * fq;
#pragma unroll
        for (int ai = 0; ai < 2; ++ai)
#pragma unroll
            for (int m = 0; m < 4; ++m) { float o[8];
#pragma unroll
                for (int n = 0; n < 2; ++n)
#pragma unroll
                    for (int j = 0; j < 4; ++j) { const float gt = acc[ai][0][m][n][j], up = acc[ai][1][m][n][j]; o[4 * n + j] = gt * frcp(1.0f + fexp2(-gt * LOG2E)) * up; }
                u32x4 w; w.x = pk2(o[0], o[1]); w.y = pk2(o[2], o[3]); w.z = pk2(o[4], o[5]); w.w = pk2(o[6], o[7]);
                *(u32x4*)(HF + (size_t)(row0 + ai * HALF + m * 16) * FF + col0) = w; }
    }
};
struct EpiResid {
    static constexpr bool PERM = true;
    const void* resid; void* out; const float* gv; int gstride; int rbf, obf;
    __device__ __forceinline__ void operator()(const AccT& acc, const Unit& u, int wr, int wc, int fr, int fq) const {
        const int row0 = u.pm * BM + wr * 64 + fr, col0 = u.pn * BM + wc * 32 + 8 * fq; const float* gp = gv + (size_t)(u.pm >> 5) * gstride + col0;
        f32x4 gg[2][2];
#pragma unroll
        for (int bj = 0; bj < 2; ++bj)
#pragma unroll
            for (int n = 0; n < 2; ++n) gg[bj][n] = *(const f32x4*)(gp + bj * HALF + 4 * n);
#pragma unroll
        for (int ai = 0; ai < 2; ++ai)
#pragma unroll
            for (int m = 0; m < 4; ++m) { const size_t off = (size_t)(row0 + ai * HALF + m * 16) * D + col0;
#pragma unroll
                for (int bj = 0; bj < 2; ++bj) { const size_t o = off + bj * HALF; f32x4 r0, r1;
                    if (rbf) { const u32x4 w = *(const u32x4*)((const bf16*)resid + o); r0 = (f32x4){bflo(w.x), bfhi(w.x), bflo(w.y), bfhi(w.y)}; r1 = (f32x4){bflo(w.z), bfhi(w.z), bflo(w.w), bfhi(w.w)}; }
                    else { r0 = *(const f32x4*)((const float*)resid + o); r1 = *(const f32x4*)((const float*)resid + o + 4); }
                    const f32x4 x0 = r0 + gg[bj][0] * acc[ai][bj][m][0], x1 = r1 + gg[bj][1] * acc[ai][bj][m][1];
                    if (obf) { u32x4 w; w.x = pk2(x0[0], x0[1]); w.y = pk2(x0[2], x0[3]); w.z = pk2(x1[0], x1[1]); w.w = pk2(x1[2], x1[3]); *(u32x4*)((bf16*)out + o) = w; }
                    else { *(f32x4*)((float*)out + o) = x0; *(f32x4*)((float*)out + o + 4) = x1; } } }
    }
};
}

constexpr size_t MiB = 1u << 20;
constexpr size_t WS_CTL = 0, CTL_ZERO_BYTES = 1 * MiB;
constexpr int CW_TMO = 0, CW_BAR = 4096, CW_LCNT = 16384;
constexpr size_t WS_MOD0 = 1 * MiB, WS_MOD1 = WS_MOD0 + 65536, WS_KVMOD = WS_MOD1 + 65536, WS_C8 = WS_KVMOD + 32768, WS_KM = WS_C8 + 8192;
constexpr size_t WS_SA = 250 * MiB, WS_SB = 253 * MiB;
constexpr size_t WS_ML = 5 * MiB;
constexpr size_t WS_WIN = 8 * MiB, WS_WG = 13 * MiB, WS_WOUT = 15 * MiB, WS_WKV = 18 * MiB, WS_WQ = 20 * MiB, WS_WO = 22 * MiB;
constexpr size_t WS_WGU0 = 24 * MiB, WS_WGU1 = 35 * MiB, WS_WD0 = 46 * MiB, WS_WD1 = 52 * MiB;
constexpr size_t ACT = 58 * MiB;
constexpr size_t WS_H_L0 = ACT, WS_Y = ACT + 32 * MiB, WS_XB = ACT + 72 * MiB, WS_XC = ACT + 112 * MiB, WS_BB = ACT + 152 * MiB;
constexpr size_t WS_H_F0 = ACT, WS_HF0 = ACT + 32 * MiB;
constexpr size_t WS_XS = 224 * MiB;
constexpr size_t DO_QB = 0, DO_KB = 32 * MiB, DO_VT = 48 * MiB;
constexpr size_t WS_LIST = ACT, WS_OP = ACT + 16 * MiB;
constexpr size_t WS_HKV = ACT + 16 * MiB, WS_H_L1 = ACT + 48 * MiB;
constexpr size_t WS_H_F1 = ACT + 112 * MiB, WS_HF1 = ACT;
constexpr size_t WS_END = 256 * MiB;
constexpr int LIST_CAP = 16384;

constexpr int RING_OFF = 0, RING_BYTES = 131072;
constexpr int LDSCTL_OFF = RING_BYTES, MISC_OFF = LDSCTL_OFF + 320;
constexpr int BT_OFF = LDSCTL_OFF + 512;
constexpr int PRE_OFF = BT_OFF + 4096;
constexpr int LDS_BYTES = 147456;
static_assert(PRE_OFF + 2048 <= LDS_BYTES, "LDS map");

#define RLX_AGENT __ATOMIC_RELAXED, __HIP_MEMORY_SCOPE_AGENT
#define LDS_WAIT() asm volatile("s_waitcnt lgkmcnt(0)" ::: "memory")

#define XB_TMO      128
#define XB_XCNT(j)  (256  + 64 * (j))
#define XB_XSUB(j)  (1280 + 64 * (j))
#define XB_XGEN(j)  (2304 + 64 * (j))
#define XB_TOP      3328
#define XB_TOPGEN   3392
#define XCD_BAR_WORDS 3456
#define XB_SPIN_CAP (1u << 18)
__device__ __forceinline__ unsigned xb_ld(unsigned* p)              { return __hip_atomic_load(p, __ATOMIC_RELAXED, __HIP_MEMORY_SCOPE_AGENT); }
__device__ __forceinline__ unsigned xb_add(unsigned* p, unsigned v) { return __hip_atomic_fetch_add(p, v, __ATOMIC_RELAXED, __HIP_MEMORY_SCOPE_AGENT); }
__device__ __forceinline__ unsigned xb_xcc_id() { return (unsigned)__builtin_amdgcn_s_getreg((3 << 11) | 20) & 0xFu; }
#define XB_SPIN(cond, bar) do { unsigned _sp = 0; while (cond) { __builtin_amdgcn_s_sleep(1); \
    if ((++_sp & 255u) == 0u) { if (xb_ld(&(bar)[XB_TMO])) break; if (_sp > XB_SPIN_CAP) { atomicAdd(&(bar)[XB_TMO], 1u); break; } } } } while (0)
struct XcdBarrier { unsigned* bar; unsigned x; volatile LAS unsigned* st; };
__device__ __forceinline__ XcdBarrier xcd_barrier_post(unsigned* bar, volatile LAS unsigned* st) {
    XcdBarrier b; b.bar = bar; b.x = xb_xcc_id(); b.st = st;
    if (threadIdx.x == 0) (void)xb_add(&bar[XB_XCNT(b.x)], 1u);
    return b;
}
__device__ __forceinline__ void xcd_barrier_complete(unsigned* bar, unsigned x, unsigned& nloc, unsigned& nx) {
    const unsigned G = gridDim.x * gridDim.y * gridDim.z;
    unsigned sum, cnt, mine, sp = 0u;
    for (;;) {
        sum = 0u; cnt = 0u; mine = 0u;
#pragma nounroll
        for (unsigned j = 0; j < 16; ++j) { const unsigned c = xb_ld(&bar[XB_XCNT(j)]); sum += c; cnt += (c > 0u) ? 1u : 0u; mine = (j == x) ? c : mine; }
        if (sum == G) break;
        __builtin_amdgcn_s_sleep(1);
        if ((++sp & 255u) == 0u) { if (xb_ld(&bar[XB_TMO])) break; if (sp > XB_SPIN_CAP) { atomicAdd(&bar[XB_TMO], 1u); break; } }
    }
    nloc = mine > 0u ? mine : 1u; nx = cnt > 0u ? cnt : 1u;
}
__device__ __forceinline__ void xcd_barrier(const XcdBarrier& b) {
    asm volatile("s_waitcnt vmcnt(0)" ::: "memory");
    __syncthreads();
    int tid0_ = threadIdx.x; asm volatile("" : "+v"(tid0_));
    if (tid0_ == 0) {
        unsigned* bar = b.bar;
        __builtin_amdgcn_s_waitcnt(0);
        unsigned nloc = b.st[0], nx = b.st[1];
        if (nloc == 0u) { xcd_barrier_complete(bar, b.x, nloc, nx); b.st[0] = nloc; b.st[1] = nx; }
        const unsigned old = xb_add(&bar[XB_XSUB(b.x)], 1u);
        const unsigned gen = old / nloc;
        if (old + 1u == (gen + 1u) * nloc) {
            __builtin_amdgcn_fence(__ATOMIC_RELEASE, "agent");
            asm volatile("s_waitcnt vmcnt(0)" ::: "memory");
            const unsigned og = xb_add(&bar[XB_TOP], 1u);
            const unsigned tg = og / nx;
            if (og + 1u == (tg + 1u) * nx) xb_add(&bar[XB_TOPGEN], 1u);
            else XB_SPIN(xb_ld(&bar[XB_TOPGEN]) == tg, bar);
            __builtin_amdgcn_fence(__ATOMIC_ACQUIRE, "agent");
            xb_add(&bar[XB_XGEN(b.x)], 1u);
            asm volatile("s_waitcnt vmcnt(0)" ::: "memory");
        } else {
            XB_SPIN(xb_ld(&bar[XB_XGEN(b.x)]) == gen, bar);
            __builtin_amdgcn_fence(__ATOMIC_ACQUIRE, "agent");
            asm volatile("s_waitcnt vmcnt(0)" ::: "memory");
        }
    }
    __syncthreads();
}

struct Args { const float* in[24]; float* out; unsigned char* ws; int ph_lo, ph_hi; };
static_assert(offsetof(Args, out) == 192 && offsetof(Args, ws) == 200, "kernarg layout");
struct Frame {
    LAS unsigned char* lds;
    int tid, lane, wave, G, bid, dry;
    const __attribute__((address_space(4))) unsigned char* kp; float* out; unsigned char* ws;
};
#define CAS __attribute__((address_space(4)))
#define ARG_IN(F, i) (((const float* const CAS*)(F).kp)[(i)])
enum { I_X = 0, I_C, I_MODW, I_MODB, I_NMIX, I_NFFN, I_WIN, I_CONVW, I_CONVB, I_WGATES, I_BGATES, I_LAMBDA, I_WOUT, I_KVMODW, I_KVMODB, I_KVNORM, I_WKV, I_WQ, I_WO, I_RELB, I_FGATE, I_FUP, I_FDOWN, I_FNORM };

__device__ __forceinline__ void fresh_ids(Frame& F) {
    int t = threadIdx.x; asm volatile("" : "+v"(t)); F.tid = t; F.lane = t & 63; F.wave = __builtin_amdgcn_readfirstlane(t >> 6);
    const CAS unsigned char* kp = (const CAS unsigned char*)__builtin_amdgcn_kernarg_segment_ptr(); asm volatile("" : "+s"(kp)); F.kp = kp;
    F.out = *(float* const CAS*)(kp + 192); F.ws = *(unsigned char* const CAS*)(kp + 200);
    int g = gridDim.x; asm volatile("" : "+s"(g)); F.G = g;
    int bx = blockIdx.x; asm volatile("" : "+s"(bx)); F.bid = bx;
}
__device__ __forceinline__ float wave_sum(float v) {
#pragma unroll
    for (int o = 1; o < 64; o <<= 1) v += __shfl_xor(v, o);
    return v;
}

__device__ __forceinline__ void p_modgemv(Frame& F) {
    LAS float* cs = (LAS float*)(F.lds + RING_OFF);
    LAS float* red = cs + 2048;
    for (int i = F.tid; i < 2048; i += 512) { const float c = ARG_IN(F, I_C)[i]; cs[i] = c * frcp(1.0f + fexp2(-c * LOG2E)); }
    __syncthreads();
    for (int it = F.bid; it < 224; it += F.G) {
        const float* W; const float* bias; float* out; int N, g;
        if (it < 96) { W = ARG_IN(F, I_MODW); N = 6 * D; g = it; bias = ARG_IN(F, I_MODB); out = (float*)(F.ws + WS_MOD0); }
        else if (it < 192) { W = ARG_IN(F, I_MODW) + (size_t)D * 6 * D; N = 6 * D; g = it - 96; bias = ARG_IN(F, I_MODB) + 6 * D; out = (float*)(F.ws + WS_MOD1); }
        else { W = ARG_IN(F, I_KVMODW); N = 2 * D; g = it - 192; bias = ARG_IN(F, I_KVMODB); out = (float*)(F.ws + WS_KVMOD); }
        const int col = g * 64 + F.lane; const int k0 = 128 * F.wave;
        const float* wp = W + (size_t)k0 * N + col;
        float a0 = 0.f, a1 = 0.f;
#pragma unroll 16
        for (int j = 0; j < 128; ++j) { const float w = __builtin_nontemporal_load(wp + (size_t)j * N); a0 += cs[k0 + j] * w; a1 += cs[1024 + k0 + j] * w; }
        red[(F.wave * 2 + 0) * 64 + F.lane] = a0; red[(F.wave * 2 + 1) * 64 + F.lane] = a1;
        __syncthreads();
        if (F.tid < 128) { const int b = F.tid >> 6, l = F.tid & 63; float s = 0.f;
#pragma unroll
            for (int w = 0; w < 8; ++w) s += red[(w * 2 + b) * 64 + l];
            out[(size_t)b * N + g * 64 + l] = s + bias[g * 64 + l]; }
        __syncthreads();
    }
}
struct TItem { const float* src; bf16* dst; int N, K, k0, n0, drow0; };
__device__ __forceinline__ void ti_load(const TItem& t, float (&wv)[32], int lane) {
#pragma unroll
    for (int i = 0; i < 32; ++i) wv[i] = __builtin_nontemporal_load(t.src + (size_t)(t.k0 + 2 * i + (lane >> 5)) * t.N + t.n0 + (lane & 31));
}
__device__ __forceinline__ void ti_store(const TItem& t, const float (&wv)[32], LAS float* scr, int lane) {
#pragma unroll
    for (int i = 0; i < 32; ++i) scr[(2 * i + (lane >> 5)) * 33 + (lane & 31)] = wv[i];
    LDS_WAIT(); asm volatile("" ::: "memory");
    const int c = lane & 7;
#pragma unroll
    for (int j = 0; j < 4; ++j) { const int n = (lane >> 3) + 8 * j; const LAS float* q = scr + (8 * c) * 33 + n;
        u32x4 o; o.x = pk2(q[0 * 33], q[1 * 33]); o.y = pk2(q[2 * 33], q[3 * 33]); o.z = pk2(q[4 * 33], q[5 * 33]); o.w = pk2(q[6 * 33], q[7 * 33]);
        *(GAS u32x4*)(t.dst + (size_t)(t.drow0 + n) * t.K + t.k0 + 8 * c) = o; }
    LDS_WAIT(); asm volatile("" ::: "memory");
}
__device__ __forceinline__ TItem ti_get(Frame& F, int stage, int r) {
    unsigned char* ws = F.ws; TItem t;
    constexpr int I_IN = (D / 64) * (2 * LW / 32), I_G = LH * (LB / 64) * (2 * LB / 32), I_SQ = (D / 64) * (D / 32), I_FU = (D / 64) * (FF / 32);
    if (stage == 0) {
        if (r < I_IN) { const int nb = 2 * LW / 32; t = TItem{ARG_IN(F, I_WIN), (bf16*)(ws + WS_WIN), 2 * LW, D, 64 * (r / nb), 32 * (r % nb), 32 * (r % nb)}; return t; } r -= I_IN;
        if (r < I_G) { const int h = r / 64, rr = r % 64, n0 = 32 * (rr % 16);
            t = TItem{ARG_IN(F, I_WGATES) + (size_t)h * LB * 2 * LB, (bf16*)(ws + WS_WG), 2 * LB, LB, 64 * (rr / 16), n0, (2 * h + ((n0 % 256) / 128)) * 256 + 128 * (n0 / 256) + (n0 % 128)}; return t; } r -= I_G;
        { const int nb = D / 32; t = TItem{ARG_IN(F, I_WOUT), (bf16*)(ws + WS_WOUT), D, LW, 64 * (r / nb), 32 * (r % nb), 32 * (r % nb)}; return t; }
    }
    const int l = stage - 1;
    if (stage == 2) {
        if (r < 3 * I_SQ) { const int w = r / I_SQ, rr = r % I_SQ, nb = D / 32;
            t = TItem{w == 0 ? ARG_IN(F, I_WKV) : (w == 1 ? ARG_IN(F, I_WQ) : ARG_IN(F, I_WO)), (bf16*)(ws + (w == 0 ? WS_WKV : (w == 1 ? WS_WQ : WS_WO))), D, D, 64 * (rr / nb), 32 * (rr % nb), 32 * (rr % nb)}; return t; } r -= 3 * I_SQ;
    }
    if (r < 2 * I_FU) { const int up = r / I_FU, rr = r % I_FU, nb = FF / 32, n0 = 32 * (rr % nb);
        t = TItem{(up ? ARG_IN(F, I_FUP) : ARG_IN(F, I_FGATE)) + (size_t)l * D * FF, (bf16*)(ws + (l ? WS_WGU1 : WS_WGU0)), FF, D, 64 * (rr / nb), n0, 256 * (n0 / 128) + 128 * up + (n0 % 128)}; return t; } r -= 2 * I_FU;
    { const int nb = D / 32; t = TItem{ARG_IN(F, I_FDOWN) + (size_t)l * FF * D, (bf16*)(ws + (l ? WS_WD1 : WS_WD0)), D, FF, 64 * (r / nb), 32 * (r % nb), 32 * (r % nb)}; return t; }
}
__device__ __forceinline__ void p_weights(Frame& F, int stage, int gw, int NGW) {
    LAS float* scr = (LAS float*)(F.lds + RING_OFF + 16384 + F.wave * 12288);
    constexpr int I_IN = (D / 64) * (2 * LW / 32), I_G = LH * (LB / 64) * (2 * LB / 32), I_OUT = (LW / 64) * (D / 32), I_SQ = (D / 64) * (D / 32), I_FU = (D / 64) * (FF / 32), I_FD = (FF / 64) * (D / 32);
    const int nitems = stage == 0 ? I_IN + I_G + I_OUT : (stage == 1 ? 2 * I_FU + I_FD : 3 * I_SQ + 2 * I_FU + I_FD);
    if (stage == 0)
        for (int i = F.bid * 512 + F.tid; i < LW; i += F.G * 512) { const float x = -ARG_IN(F, I_LAMBDA)[i]; const float sp = fmaxf(x, 0.f) + log1pf(__expf(-fabsf(x))); ((float*)(F.ws + WS_C8))[i] = 8.0f * sp; }
    int it = gw; if (it >= nitems) return;
    float va[32], vb[32];
    TItem ta = ti_get(F, stage, it), tb = ta; ti_load(ta, va, F.lane);
    for (;;) {
        const int it2 = it + NGW; const bool m2 = it2 < nitems;
        if (m2) { tb = ti_get(F, stage, it2); ti_load(tb, vb, F.lane); }
        ti_store(ta, va, scr, F.lane);
        if (!m2) break;
        const int it3 = it2 + NGW; const bool m3 = it3 < nitems;
        if (m3) { ta = ti_get(F, stage, it3); ti_load(ta, va, F.lane); }
        ti_store(tb, vb, scr, F.lane);
        if (!m3) break;
        it = it3;
    }
}
__device__ __forceinline__ void p_weights_bubble(Frame& F, int stage) {
    const int G = F.G, rounds = (640 + G - 1) / G, full = 640 - (rounds - 1) * G;
    if (F.dry) return;
    if (full < G) { if (F.bid >= full) p_weights(F, stage, (F.bid - full) * 8 + F.wave, (G - full) * 8); }
    else p_weights(F, stage, F.bid * 8 + F.wave, G * 8);
}
template <int NOUT, bool XBF>
__device__ __forceinline__ void norm_mod_rows(Frame& F, const void* X, const float* g0, const float* sh0, const float* sc0, int bs0, bf16* o0,
                                              const float* g1, const float* sh1, const float* sc1, int bs1, bf16* o1) {
    const int gw = F.bid * 8 + F.wave, NGW = F.G * 8;
    for (int b = 0; b < BATCH; ++b) {
        f32x4 gs0[4], sv0[4], gs1[4], sv1[4];
#pragma unroll
        for (int j = 0; j < 4; ++j) { const int c = 8 * (F.lane + 64 * (j >> 1)) + 4 * (j & 1);
            const f32x4 g = *(const f32x4*)(g0 + c), sc = *(const f32x4*)(sc0 + (size_t)b * bs0 + c); gs0[j] = g * (sc + 1.0f); sv0[j] = *(const f32x4*)(sh0 + (size_t)b * bs0 + c);
            if (NOUT == 2) { const f32x4 gB = *(const f32x4*)(g1 + c), scB = *(const f32x4*)(sc1 + (size_t)b * bs1 + c); gs1[j] = gB * (scB + 1.0f); sv1[j] = *(const f32x4*)(sh1 + (size_t)b * bs1 + c); } }
        u32x4 rawb[2]; f32x4 rawf[4];
        auto load_row = [&](int m) {
            if constexpr (XBF) { const u32x4* xr = (const u32x4*)((const bf16*)X + (size_t)m * D) + F.lane; rawb[0] = xr[0]; rawb[1] = xr[64]; }
            else { const f32x4* xr = (const f32x4*)((const float*)X + (size_t)m * D) + 2 * F.lane; rawf[0] = xr[0]; rawf[1] = xr[1]; rawf[2] = xr[128]; rawf[3] = xr[129]; } };
        int m = b * SEQ + gw; const int mend = (b + 1) * SEQ;
        if (m < mend) load_row(m);
        for (; m < mend; m += NGW) {
            f32x4 v[4]; float s = 0.f;
            if constexpr (XBF) {
#pragma unroll
                for (int jj = 0; jj < 2; ++jj) { const u32x4 w = rawb[jj]; v[2 * jj] = (f32x4){bflo(w.x), bfhi(w.x), bflo(w.y), bfhi(w.y)}; v[2 * jj + 1] = (f32x4){bflo(w.z), bfhi(w.z), bflo(w.w), bfhi(w.w)}; }
            } else {
#pragma unroll
                for (int j = 0; j < 4; ++j) v[j] = rawf[j]; }
            if (m + NGW < mend) load_row(m + NGW);
#pragma unroll
            for (int j = 0; j < 4; ++j) s += (v[j].x * v[j].x + v[j].y * v[j].y) + (v[j].z * v[j].z + v[j].w * v[j].w);
            const float rstd = 1.0f / sqrtf(wave_sum(s) * (1.0f / D) + RMS_EPS);
            u32x4* p0 = (u32x4*)(o0 + (size_t)m * D) + F.lane;
#pragma unroll
            for (int jj = 0; jj < 2; ++jj) { const f32x4 y0 = v[2 * jj] * rstd * gs0[2 * jj] + sv0[2 * jj], y1 = v[2 * jj + 1] * rstd * gs0[2 * jj + 1] + sv0[2 * jj + 1];
                u32x4 w; w.x = pk2(y0.x, y0.y); w.y = pk2(y0.z, y0.w); w.z = pk2(y1.x, y1.y); w.w = pk2(y1.z, y1.w); p0[64 * jj] = w; }
            if (NOUT == 2) { u32x4* p1 = (u32x4*)(o1 + (size_t)m * D) + F.lane;
#pragma unroll
                for (int jj = 0; jj < 2; ++jj) { const f32x4 y0 = v[2 * jj] * rstd * gs1[2 * jj] + sv1[2 * jj], y1 = v[2 * jj + 1] * rstd * gs1[2 * jj + 1] + sv1[2 * jj + 1];
                    u32x4 w; w.x = pk2(y0.x, y0.y); w.y = pk2(y0.z, y0.w); w.z = pk2(y1.x, y1.y); w.w = pk2(y1.z, y1.w); p1[64 * jj] = w; } }
        }
    }
}
__device__ __forceinline__ void final_norm_rows(Frame& F, const float* X, float* O, const float* g) {
    const int gw = F.bid * 8 + F.wave, NGW = F.G * 8;
    f32x4 gg[4];
#pragma unroll
    for (int j = 0; j < 4; ++j) gg[j] = *(const f32x4*)(g + 4 * (F.lane + 64 * j));
    f32x4 nx[4];
    int m = gw;
    if (m < M) { const f32x4* xr = (const f32x4*)(X + (size_t)m * D) + F.lane;
#pragma unroll
        for (int j = 0; j < 4; ++j) nx[j] = xr[64 * j]; }
    for (; m < M; m += NGW) {
        f32x4 v[4]; float s = 0.f;
#pragma unroll
        for (int j = 0; j < 4; ++j) v[j] = nx[j];
        if (m + NGW < M) { const f32x4* xr = (const f32x4*)(X + (size_t)(m + NGW) * D) + F.lane;
#pragma unroll
            for (int j = 0; j < 4; ++j) nx[j] = xr[64 * j]; }
#pragma unroll
        for (int j = 0; j < 4; ++j) s += (v[j].x * v[j].x + v[j].y * v[j].y) + (v[j].z * v[j].z + v[j].w * v[j].w);
        const float rstd = 1.0f / sqrtf(wave_sum(s) * (1.0f / D) + RMS_EPS);
        f32x4* orow = (f32x4*)(O + (size_t)m * D) + F.lane;
#pragma unroll
        for (int j = 0; j < 4; ++j) orow[64 * j] = v[j] * rstd * gg[j];
    }
}

__device__ __forceinline__ void p_conv(Frame& F) {
    const bf16* XB = (const bf16*)(F.ws + WS_XB); bf16* XC = (bf16*)(F.ws + WS_XC);
    const float* cw = ARG_IN(F, I_CONVW); const float* cb = ARG_IN(F, I_CONVB);
    const int NT = F.G * 512;
    for (int gid = F.bid * 512 + F.tid; gid < (M / 32) * (LW / 8); gid += NT) {
        const int cg = gid % (LW / 8), chunk = gid / (LW / 8), ch = cg * 8, m0 = chunk * 32;
        float w0[8], w1[8], w2[8], w3[8], bb[8];
#pragma unroll
        for (int e = 0; e < 8; ++e) { w0[e] = cw[ch + e]; w1[e] = cw[LW + ch + e]; w2[e] = cw[2 * LW + ch + e]; w3[e] = cw[3 * LW + ch + e]; bb[e] = cb[ch + e]; }
        float x3[8], x2[8], x1[8], x0[8];
        if ((m0 % SEQ) == 0) {
#pragma unroll
            for (int e = 0; e < 8; ++e) { x3[e] = 0.f; x2[e] = 0.f; x1[e] = 0.f; }
        } else {
            unpack8(*(const u32x4*)(XB + (size_t)(m0 - 3) * LW + ch), x3); unpack8(*(const u32x4*)(XB + (size_t)(m0 - 2) * LW + ch), x2); unpack8(*(const u32x4*)(XB + (size_t)(m0 - 1) * LW + ch), x1);
        }
#pragma unroll 4
        for (int r = 0; r < 32; ++r) {
            unpack8(*(const u32x4*)(XB + (size_t)(m0 + r) * LW + ch), x0);
            float o[8];
#pragma unroll
            for (int e = 0; e < 8; ++e) { o[e] = bb[e] + w0[e] * x3[e] + w1[e] * x2[e] + w2[e] * x1[e] + w3[e] * x0[e]; x3[e] = x2[e]; x2[e] = x1[e]; x1[e] = x0[e]; }
            u32x4 w; w.x = pk2(o[0], o[1]); w.y = pk2(o[2], o[3]); w.z = pk2(o[4], o[5]); w.w = pk2(o[6], o[7]);
            *(u32x4*)(XC + (size_t)(m0 + r) * LW + ch) = w;
        }
    }
}
constexpr int SCH = 32, NCH = SEQ / SCH, CG = LW / 8;
__device__ __forceinline__ void p_scan1(Frame& F) {
    const u32x4* LA = (const u32x4*)(F.ws + WS_XB); const u32x4* BB = (const u32x4*)(F.ws + WS_BB);
    float* SA = (float*)(F.ws + WS_SA); float* SB = (float*)(F.ws + WS_SB);
    const int NT = F.G * 512;
    for (int gid = F.bid * 512 + F.tid; gid < BATCH * NCH * CG; gid += NT) {
        const int g = gid % CG, bc = gid / CG;
        const u32x4* la = LA + (size_t)bc * SCH * CG + g; const u32x4* bb = BB + (size_t)bc * SCH * CG + g;
        float h[8], sm[8];
#pragma unroll
        for (int e = 0; e < 8; ++e) { h[e] = 0.f; sm[e] = 0.f; }
#pragma unroll 1
        for (int r0 = 0; r0 < SCH; r0 += 16) {
            u32x4 lv[16], bv[16];
#pragma unroll
            for (int r = 0; r < 16; ++r) { lv[r] = la[(size_t)(r0 + r) * CG]; bv[r] = bb[(size_t)(r0 + r) * CG]; }
#pragma unroll
            for (int r = 0; r < 16; ++r) { float l[8], u[8]; unpack8(lv[r], l); unpack8(bv[r], u);
#pragma unroll
                for (int e = 0; e < 8; ++e) { h[e] = fexp2(l[e] * LOG2E) * h[e] + u[e]; sm[e] += l[e]; } }
        }
        f32x4* sa = (f32x4*)(SA + (size_t)bc * LW + 8 * g); f32x4* sb = (f32x4*)(SB + (size_t)bc * LW + 8 * g);
        sa[0] = (f32x4){fexp2(sm[0] * LOG2E), fexp2(sm[1] * LOG2E), fexp2(sm[2] * LOG2E), fexp2(sm[3] * LOG2E)};
        sa[1] = (f32x4){fexp2(sm[4] * LOG2E), fexp2(sm[5] * LOG2E), fexp2(sm[6] * LOG2E), fexp2(sm[7] * LOG2E)};
        sb[0] = (f32x4){h[0], h[1], h[2], h[3]}; sb[1] = (f32x4){h[4], h[5], h[6], h[7]};
    }
}
__device__ __forceinline__ void p_scan_carry(Frame& F) {
    const float* SA = (const float*)(F.ws + WS_SA); float* SB = (float*)(F.ws + WS_SB);
    LAS float* segA = (LAS float*)(F.lds + RING_OFF); LAS float* segB = segA + 512;
    const int seg = F.tid >> 5, cl = F.tid & 31;
    for (int it = F.bid; it < BATCH * (LW / 32); it += F.G) {
        const int b = it / (LW / 32), ch = (it % (LW / 32)) * 32 + cl;
        const size_t base = (size_t)(b * NCH + 16 * seg) * LW + ch;
        float a[16], bq[16];
#pragma unroll
        for (int j = 0; j < 16; ++j) { a[j] = SA[base + (size_t)j * LW]; bq[j] = SB[base + (size_t)j * LW]; }
        float A = 1.f, B = 0.f;
#pragma unroll
        for (int j = 0; j < 16; ++j) { B = a[j] * B + bq[j]; A *= a[j]; }
        segA[seg * 32 + cl] = A; segB[seg * 32 + cl] = B;
        __syncthreads();
        float H = 0.f;
        for (int s2 = 0; s2 < seg; ++s2) H = segA[s2 * 32 + cl] * H + segB[s2 * 32 + cl];
#pragma unroll
        for (int j = 0; j < 16; ++j) { SB[base + (size_t)j * LW] = H; H = a[j] * H + bq[j]; }
        __syncthreads();
    }
}
__device__ __forceinline__ void p_scan2(Frame& F) {
    const u32x4* LA = (const u32x4*)(F.ws + WS_XB); const u32x4* BB = (const u32x4*)(F.ws + WS_BB);
    u32x4* Y = (u32x4*)(F.ws + WS_Y); u32x4* YO = F.dry ? (u32x4*)(F.ws + WS_XC) : Y;
    const float* SB = (const float*)(F.ws + WS_SB);
    const int NT = F.G * 512;
    for (int gid = F.bid * 512 + F.tid; gid < BATCH * NCH * CG; gid += NT) {
        const int g = gid % CG, bc = gid / CG;
        const size_t base = (size_t)bc * SCH * CG + g;
        float h[8];
        { const f32x4 c0 = *(const f32x4*)(SB + (size_t)bc * LW + 8 * g), c1 = *(const f32x4*)(SB + (size_t)bc * LW + 8 * g + 4);
          h[0] = c0.x; h[1] = c0.y; h[2] = c0.z; h[3] = c0.w; h[4] = c1.x; h[5] = c1.y; h[6] = c1.z; h[7] = c1.w; }
#pragma unroll 1
        for (int r0 = 0; r0 < SCH; r0 += 8) {
            u32x4 lv[8], bv[8], yv[8];
#pragma unroll
            for (int r = 0; r < 8; ++r) { const size_t o = base + (size_t)(r0 + r) * CG; lv[r] = LA[o]; bv[r] = BB[o]; yv[r] = Y[o]; }
#pragma unroll
            for (int r = 0; r < 8; ++r) { float l[8], u[8], y[8]; unpack8(lv[r], l); unpack8(bv[r], u); unpack8(yv[r], y);
#pragma unroll
                for (int e = 0; e < 8; ++e) h[e] = fexp2(l[e] * LOG2E) * h[e] + u[e];
                u32x4 w; w.x = pk2(h[0] * y[0], h[1] * y[1]); w.y = pk2(h[2] * y[2], h[3] * y[3]); w.z = pk2(h[4] * y[4], h[5] * y[5]); w.w = pk2(h[6] * y[6], h[7] * y[7]);
                YO[base + (size_t)(r0 + r) * CG] = w; }
        }
    }
}

__device__ __forceinline__ void p_kmean(Frame& F) {
    if (F.dry && DRY_VARIANT == 5) return;
    const bf16* KB = (const bf16*)((unsigned char*)F.out + DO_KB); float* KM = (float*)(F.ws + WS_KM);
    LAS float* red = (LAS float*)(F.lds + RING_OFF);
    const int dg = F.lane & 15, rg = F.wave * 4 + (F.lane >> 4);
    for (int it = F.bid; it < BATCH * NKV * NB; it += F.G) {
        const int n = it % NB, kvh = (it / NB) % NKV, b = it / (NB * NKV);
        const u32x4* kp = (const u32x4*)(KB + (size_t)(b * SEQ + n * BLK + rg * 8) * (NKV * HD) + kvh * HD) + dg;
        float sm[8];
#pragma unroll
        for (int e = 0; e < 8; ++e) sm[e] = 0.f;
        u32x4 kv[8];
#pragma unroll
        for (int r = 0; r < 8; ++r) kv[r] = kp[(size_t)r * (NKV * HD / 8)];
#pragma unroll
        for (int r = 0; r < 8; ++r) { float x[8]; unpack8(kv[r], x);
#pragma unroll
            for (int e = 0; e < 8; ++e) sm[e] += x[e]; }
#pragma unroll
        for (int e = 0; e < 8; ++e) red[rg * 128 + 8 * dg + e] = sm[e];
        __syncthreads();
        if (F.tid < 128) { float t = 0.f;
#pragma unroll
            for (int w = 0; w < 32; ++w) t += red[w * 128 + F.tid];
            KM[(size_t)it * HD + F.tid] = t * (1.0f / BLK); }
        __syncthreads();
    }
}
#define MFMA32(a, b, c) __builtin_amdgcn_mfma_f32_32x32x16_bf16((a), (b), (c), 0, 0, 0)
__device__ __forceinline__ void top3_insert(float g, int n, float& v0, float& v1, float& v2, int& i0, int& i1, int& i2) {
    const bool c0 = g > v0, c1 = g > v1, c2 = g > v2;
    const float nv2 = c1 ? v1 : (c2 ? g : v2); const int ni2 = c1 ? i1 : (c2 ? n : i2);
    const float nv1 = c0 ? v0 : (c1 ? g : v1); const int ni1 = c0 ? i0 : (c1 ? n : i1);
    v0 = c0 ? g : v0; i0 = c0 ? n : i0; v1 = nv1; i1 = ni1; v2 = nv2; i2 = ni2;
}
__device__ __forceinline__ void gate_group(const bf16* QB, const bf16x8 (&kh)[8], const bf16x8 (&kl)[8], LAS int* cntl, int b, int tg, int h, int kvh, int li, int hi, int own,
                                           int& s0, int& s1, int& s2, int& p0, int& p1, int& p2) {
    const int t = tg + li;
    const bf16* qp = QB + (size_t)(b * SEQ + t) * D + h * HD + 8 * hi;
    f32x16 acc;
#pragma unroll
    for (int r = 0; r < 16; ++r) acc[r] = 0.f;
#pragma unroll
    for (int ks = 0; ks < 8; ++ks) { const bf16x8 qf = *(const bf16x8*)(qp + 16 * ks); acc = MFMA32(kh[ks], qf, acc); acc = MFMA32(kl[ks], qf, acc); }
    int i0 = -1, i1 = -1, i2 = -1; float v0 = -3.0e38f, v1 = -3.0e38f, v2 = -3.0e38f;
#pragma unroll
    for (int r = 0; r < 16; ++r) { const int n = (r & 3) + 8 * (r >> 2) + 4 * hi; top3_insert(n < own ? acc[r] : -3.0e38f, n, v0, v1, v2, i0, i1, i2); }
    const float w0 = __shfl_xor(v0, 32), w1 = __shfl_xor(v1, 32), w2 = __shfl_xor(v2, 32);
    const int j0 = __shfl_xor(i0, 32), j1 = __shfl_xor(i1, 32), j2 = __shfl_xor(i2, 32);
    top3_insert(j0 >= 0 ? w0 : -3.0e38f, j0, v0, v1, v2, i0, i1, i2);
    top3_insert(j1 >= 0 ? w1 : -3.0e38f, j1, v0, v1, v2, i0, i1, i2);
    top3_insert(j2 >= 0 ? w2 : -3.0e38f, j2, v0, v1, v2, i0, i1, i2);
    s0 = i0; s1 = i1; s2 = i2; p0 = 0; p1 = 0; p2 = 0;
    if (hi == 0) {
        if (i0 >= 0) p0 = __hip_atomic_fetch_add(&cntl[kvh * NB + i0], 1, __ATOMIC_RELAXED, __HIP_MEMORY_SCOPE_WORKGROUP);
        if (i1 >= 0) p1 = __hip_atomic_fetch_add(&cntl[kvh * NB + i1], 1, __ATOMIC_RELAXED, __HIP_MEMORY_SCOPE_WORKGROUP);
        if (i2 >= 0) p2 = __hip_atomic_fetch_add(&cntl[kvh * NB + i2], 1, __ATOMIC_RELAXED, __HIP_MEMORY_SCOPE_WORKGROUP);
    }
}
__device__ __forceinline__ void p_gate(Frame& F) {
    const bf16* QB = (const bf16*)((unsigned char*)F.out + DO_QB); const float* KM = (const float*)(F.ws + WS_KM);
    unsigned* LIST = (unsigned*)(F.ws + (F.dry ? WS_OP : WS_LIST)); unsigned* gcnt = (unsigned*)(F.ws + WS_CTL) + CW_LCNT + (F.dry ? 256 : 0);
    LAS int* cntl = (LAS int*)(F.lds + RING_OFF);
    const int h = F.wave, kvh = h >> 1, li = F.lane & 31, hi = F.lane >> 5;
    for (int tile = F.bid; tile < M / 64; tile += F.G) {
        const int b = tile / (SEQ / 64), t0 = (tile % (SEQ / 64)) * 64, own = t0 / BLK;
        if (F.tid < 256) cntl[F.tid] = 0;
        __syncthreads();
        bf16x8 kh[8], kl[8];
        { const float* kmp = KM + ((size_t)((b * NKV + kvh) * NB + li)) * HD + 8 * hi;
#pragma unroll
          for (int ks = 0; ks < 8; ++ks) { const f32x4 a = *(const f32x4*)(kmp + 16 * ks), c = *(const f32x4*)(kmp + 16 * ks + 4);
              u32x4 wh; wh.x = pk2(a.x, a.y); wh.y = pk2(a.z, a.w); wh.z = pk2(c.x, c.y); wh.w = pk2(c.z, c.w);
              u32x4 wl; wl.x = pk2(a.x - bflo(wh.x), a.y - bfhi(wh.x)); wl.y = pk2(a.z - bflo(wh.y), a.w - bfhi(wh.y)); wl.z = pk2(c.x - bflo(wh.z), c.y - bfhi(wh.z)); wl.w = pk2(c.z - bflo(wh.w), c.w - bfhi(wh.w));
              kh[ks] = __builtin_bit_cast(bf16x8, wh); kl[ks] = __builtin_bit_cast(bf16x8, wl); } }
        int sa0, sa1, sa2, pa0, pa1, pa2, sb0, sb1, sb2, pb0, pb1, pb2;
        gate_group(QB, kh, kl, cntl, b, t0, h, kvh, li, hi, own, sa0, sa1, sa2, pa0, pa1, pa2);
        gate_group(QB, kh, kl, cntl, b, t0 + 32, h, kvh, li, hi, own, sb0, sb1, sb2, pb0, pb1, pb2);
        __syncthreads();
        if (F.tid < 128) { const int c = cntl[F.tid]; int base = 0; if (c > 0) base = (int)atomicAdd(&gcnt[b * 128 + F.tid], (unsigned)c); cntl[128 + F.tid] = base; }
        __syncthreads();
        if (hi == 0) {
            const size_t lb = (size_t)(b * 128 + kvh * NB); const int cb = 128 + kvh * NB;
            const unsigned ea = ((unsigned)(t0 + li) << 3) | ((unsigned)(h & 1) << 2), eb = ((unsigned)(t0 + 32 + li) << 3) | ((unsigned)(h & 1) << 2);
            if (sa0 >= 0) LIST[(lb + sa0) * LIST_CAP + cntl[cb + sa0] + pa0] = ea | 0u;
            if (sa1 >= 0) LIST[(lb + sa1) * LIST_CAP + cntl[cb + sa1] + pa1] = ea | 1u;
            if (sa2 >= 0) LIST[(lb + sa2) * LIST_CAP + cntl[cb + sa2] + pa2] = ea | 2u;
            if (sb0 >= 0) LIST[(lb + sb0) * LIST_CAP + cntl[cb + sb0] + pb0] = eb | 0u;
            if (sb1 >= 0) LIST[(lb + sb1) * LIST_CAP + cntl[cb + sb1] + pb1] = eb | 1u;
            if (sb2 >= 0) LIST[(lb + sb2) * LIST_CAP + cntl[cb + sb2] + pb2] = eb | 2u;
        }
        __syncthreads();
    }
}

constexpr int HBUF = 65536;
__device__ __forceinline__ void build_bias_table(Frame& F) {
    LAS float* BT = (LAS float*)(F.lds + BT_OFF);
    for (int i = F.tid; i < NH * 128; i += 512) { const int h = i >> 7, d = i & 127; int bk;
        if (d < 16) bk = d; else { bk = 16 + (int)(logf((float)d / 16.0f) / 2.0794415416798357f * 16.0f); bk = bk < 31 ? bk : 31; }
        BT[i] = ARG_IN(F, I_RELB)[h * 32 + bk] * LOG2E; }
}
__device__ __forceinline__ void glds_half(Frame& F, int b, int kvh, int n, int half, int buf) {
    int ln = F.lane; asm volatile("" : "+v"(ln));
    const int wv = F.wave;
    const char* kb = (const char*)((const bf16*)((unsigned char*)F.out + DO_KB) + (size_t)(b * SEQ + n * BLK + half * 128 + 16 * wv) * (NKV * HD) + kvh * HD);
    const char* vb = (const char*)((const bf16*)((unsigned char*)F.out + DO_VT) + (size_t)(kvh * HD + 16 * wv) * M + b * SEQ + n * BLK + half * 128);
    const int r4 = ln >> 4, slot = ln & 15;
#pragma unroll
    for (int i = 0; i < 4; ++i) { const int rr = 4 * i + r4; const unsigned ko = (unsigned)(rr * (NKV * HD) * 2 + ((slot ^ rr) << 4));
        __builtin_amdgcn_global_load_lds((const unsigned*)(kb + ko), (LAS unsigned*)(F.lds + RING_OFF + buf * HBUF + (wv * 4 + i) * 1024), 16, 0, 0); }
#pragma unroll
    for (int i = 0; i < 4; ++i) { const int rr = 4 * i + r4; const unsigned vo = (unsigned)rr * (unsigned)(M * 2) + (unsigned)((slot ^ rr) << 4);
        __builtin_amdgcn_global_load_lds((const unsigned*)(vb + vo), (LAS unsigned*)(F.lds + RING_OFF + buf * HBUF + 32768 + (wv * 4 + i) * 1024), 16, 0, 0); }
}
#define ATT_WAIT_BAR() do { asm volatile("s_waitcnt vmcnt(0) lgkmcnt(0)" ::: "memory"); __builtin_amdgcn_s_barrier(); asm volatile("" ::: "memory"); } while (0)
struct AttState { f32x16 o[4]; float m, l; };
template <int MODE>
__device__ __forceinline__ void attn_tile(Frame& F, AttState& st, const bf16x8 (&qf)[8], const int kbase, const int vbase, int kt, int qpos, int hbase, float cb) {
    const int hi = F.lane >> 5;
    const LAS float* BT = (const LAS float*)(F.lds + BT_OFF) + hbase;
    const LAS unsigned char* hb = F.lds + RING_OFF + (kt >> 1) * HBUF;
    const int kl = kt & 1;
    f32x16 s[2];
#pragma unroll
    for (int sub = 0; sub < 2; ++sub) {
        f32x16 a;
#pragma unroll
        for (int r = 0; r < 16; ++r) a[r] = 0.f;
#pragma unroll
        for (int ks = 0; ks < 8; ++ks) { const bf16x8 kf = *(const LAS bf16x8*)(hb + (kbase ^ (ks << 5)) + (64 * kl + 32 * sub) * 256); a = MFMA32(kf, qf[ks], a); }
        s[sub] = a;
    }
    float mx = -1.0e30f;
#pragma unroll
    for (int sub = 0; sub < 2; ++sub)
#pragma unroll
        for (int r = 0; r < 16; ++r) { const int key = 64 * kt + 32 * sub + (r & 7) + 8 * hi + 16 * (r >> 3);
            float v = s[sub][r];
            if (MODE == 0) v += cb;
            else { const int dist = qpos - key; const int idx = dist < 0 ? 0 : (dist > 127 ? 127 : dist); v += BT[idx]; if (MODE == 2 && dist < 0) v = -1.0e30f; }
            s[sub][r] = v; mx = fmaxf(mx, v); }
    mx = fmaxf(mx, __shfl_xor(mx, 32));
    if (__any(mx > st.m)) {
        const float mnew = fmaxf(st.m, mx), alpha = fexp2(st.m - mnew);
        st.m = mnew; st.l *= alpha;
#pragma unroll
        for (int db = 0; db < 4; ++db) st.o[db] = st.o[db] * alpha;
    }
    const float mcur = st.m;
    float ls = 0.f;
#pragma unroll
    for (int sub = 0; sub < 2; ++sub) {
        bf16x8 pf[2];
#pragma unroll
        for (int sh = 0; sh < 2; ++sh) { float p[8];
#pragma unroll
            for (int j = 0; j < 8; ++j) { p[j] = fexp2(s[sub][8 * sh + j] - mcur); ls += p[j]; }
            u32x4 w; w.x = pk2(p[0], p[1]); w.y = pk2(p[2], p[3]); w.z = pk2(p[4], p[5]); w.w = pk2(p[6], p[7]);
            pf[sh] = __builtin_bit_cast(bf16x8, w); }
#pragma unroll
        for (int db = 0; db < 4; ++db)
#pragma unroll
            for (int sh = 0; sh < 2; ++sh) { const bf16x8 vf = *(const LAS bf16x8*)(hb + 32768 + (vbase ^ ((kl * 4 + sub * 2 + sh) << 5)) + db * 32 * 256);
                st.o[db] = MFMA32(vf, pf[sh], st.o[db]); }
    }
    st.l += ls;
}
__device__ __forceinline__ void attn_lane_offsets(int lane, int& kbase, int& vbase) {
    const int i = lane & 31, hi = lane >> 5;
    const int pi = (i & ~12) | ((i & 8) >> 1) | ((i & 4) << 1);
    kbase = pi * 256 + (((hi ^ pi) & 15) << 4);
    vbase = i * 256 + (((hi ^ i) & 15) << 4);
}
__device__ __forceinline__ void attn_init(AttState& st) {
#pragma unroll
    for (int db = 0; db < 4; ++db)
#pragma unroll
        for (int r = 0; r < 16; ++r) st.o[db][r] = 0.f;
    st.m = -1.0e30f; st.l = 0.f;
}
__device__ __forceinline__ void store_row16(const f32x16 (&o)[4], float scale, bf16* rowp, int hi) {
#pragma unroll
    for (int db = 0; db < 4; ++db)
#pragma unroll
        for (int g = 0; g < 4; g += 2) {
            unsigned a0 = pk2(o[db][4 * g] * scale, o[db][4 * g + 1] * scale), a1 = pk2(o[db][4 * g + 2] * scale, o[db][4 * g + 3] * scale);
            unsigned b0 = pk2(o[db][4 * g + 4] * scale, o[db][4 * g + 5] * scale), b1 = pk2(o[db][4 * g + 6] * scale, o[db][4 * g + 7] * scale);
            const auto r0 = __builtin_amdgcn_permlane32_swap(a0, b0, false, false); const auto r1 = __builtin_amdgcn_permlane32_swap(a1, b1, false, false);
            u32x4 w; w.x = r0[0]; w.y = r1[0]; w.z = r0[1]; w.w = r1[1];
            *(u32x4*)(rowp + 32 * db + 8 * (g + hi)) = w; }
}
__device__ __forceinline__ void addrow16(f32x16 (&o)[4], float cs, const bf16* rowp, int hi) {
#pragma unroll
    for (int db = 0; db < 4; ++db)
#pragma unroll
        for (int g = 0; g < 4; g += 2) {
            const u32x4 w = *(const u32x4*)(rowp + 32 * db + 8 * (g + hi));
            const auto r0 = __builtin_amdgcn_permlane32_swap(w.x, w.z, false, false); const auto r1 = __builtin_amdgcn_permlane32_swap(w.y, w.w, false, false);
            o[db][4 * g] += cs * bflo(r0[0]); o[db][4 * g + 1] += cs * bfhi(r0[0]); o[db][4 * g + 2] += cs * bflo(r1[0]); o[db][4 * g + 3] += cs * bfhi(r1[0]);
            o[db][4 * g + 4] += cs * bflo(r0[1]); o[db][4 * g + 5] += cs * bfhi(r0[1]); o[db][4 * g + 6] += cs * bflo(r1[1]); o[db][4 * g + 7] += cs * bfhi(r1[1]); }
}
__device__ __forceinline__ unsigned pk4_fp8(float a, float b, float c, float d) { unsigned w = 0; w = __builtin_amdgcn_cvt_pk_fp8_f32(a, b, w, false); w = __builtin_amdgcn_cvt_pk_fp8_f32(c, d, w, true); return w; }
__device__ __forceinline__ void store_row_fp8(const f32x16 (&o)[4], float scale, unsigned char* rowp, int hi) {
#pragma unroll
    for (int db = 0; db < 4; ++db) {
        unsigned W[4];
#pragma unroll
        for (int g = 0; g < 4; ++g) W[g] = pk4_fp8(o[db][4 * g] * scale, o[db][4 * g + 1] * scale, o[db][4 * g + 2] * scale, o[db][4 * g + 3] * scale);
        const auto r0 = __builtin_amdgcn_permlane32_swap(W[0], W[2], false, false);
        const auto r1 = __builtin_amdgcn_permlane32_swap(W[1], W[3], false, false);
        u32x4 w; w.x = r0[0]; w.y = r0[1]; w.z = r1[0]; w.w = r1[1];
        *(u32x4*)(rowp + 32 * db + 16 * hi) = w; }
}
__device__ __forceinline__ void addrow_fp8(f32x16 (&o)[4], float cs, const unsigned char* rowp, int hi) {
#pragma unroll
    for (int db = 0; db < 4; ++db) {
        const u32x4 x = *(const u32x4*)(rowp + 32 * db + 16 * hi);
        const auto r0 = __builtin_amdgcn_permlane32_swap(x.x, x.y, false, false);
        const auto r1 = __builtin_amdgcn_permlane32_swap(x.z, x.w, false, false);
        const unsigned G[4] = {r0[0], r1[0], r0[1], r1[1]};
#pragma unroll
        for (int g = 0; g < 4; ++g) { o[db][4 * g] += cs * __builtin_amdgcn_cvt_f32_fp8(G[g], 0); o[db][4 * g + 1] += cs * __builtin_amdgcn_cvt_f32_fp8(G[g], 1);
            o[db][4 * g + 2] += cs * __builtin_amdgcn_cvt_f32_fp8(G[g], 2); o[db][4 * g + 3] += cs * __builtin_amdgcn_cvt_f32_fp8(G[g], 3); } }
}
__device__ __forceinline__ int find_list(const LAS int* pre, int item) {
    int lo = 0, hi = 256;
#pragma unroll
    for (int it = 0; it < 8; ++it) { const int mid = (lo + hi) >> 1; if (pre[mid] <= item) lo = mid; else hi = mid; }
    return __builtin_amdgcn_readfirstlane(lo);
}

__device__ __forceinline__ void p_attn_sparse(Frame& F) {
    const bf16* QB = (const bf16*)((unsigned char*)F.out + DO_QB); const unsigned* LIST = (const unsigned*)(F.ws + WS_LIST);
    unsigned* gcnt = (unsigned*)(F.ws + WS_CTL) + CW_LCNT;
    bf16* OP = (bf16*)(F.ws + WS_OP); f32x2* ML = (f32x2*)(F.ws + WS_ML);
    LAS int* pre = (LAS int*)(F.lds + PRE_OFF);
    LAS int* cnts = pre + 264;
    build_bias_table(F);
    if (F.tid < 256) { const int c = (int)__hip_atomic_load(gcnt + F.tid, RLX_AGENT); cnts[F.tid] = c; pre[F.tid + 1] = (c + 255) >> 8; }
    __syncthreads();
    if (F.tid == 0) { int s = 0; pre[0] = 0; for (int i = 1; i <= 256; ++i) { s += pre[i]; pre[i] = s; } }
    __syncthreads();
    const int total = (F.dry && DRY_VARIANT == 3) ? 0 : pre[256];
    int kbase, vbase; attn_lane_offsets(F.lane, kbase, vbase);
    const int hi = F.lane >> 5;
    int item = F.bid;
    int l = 0;
    unsigned ent = 0; bf16x8 qf[8]; bool valid = false;
#define SPARSE_FETCH_ENT(l_, item_) do { const int chunk_ = (item_) - pre[l_]; const int cnt_ = cnts[l_]; const int ri_ = chunk_ * 256 + F.wave * 32 + (F.lane & 31); \
        ent = LIST[(size_t)(l_) * LIST_CAP + (ri_ < cnt_ ? ri_ : cnt_ - 1)]; } while (0)
#define SPARSE_FETCH_Q(l_) do { const int t_ = (int)(ent >> 3), h_ = 2 * (((l_) >> 5) & 3) + (int)((ent >> 2) & 1u); const unsigned mrow_ = (unsigned)(((l_) >> 7) * SEQ + t_); \
        _Pragma("unroll") for (int ks = 0; ks < 8; ++ks) qf[ks] = *(const bf16x8*)(QB + (mrow_ * D + h_ * HD + 16 * ks + 8 * hi)); } while (0)
    if (item < total) { l = find_list(pre, item); glds_half(F, l >> 7, (l >> 5) & 3, l & 31, 0, 0); SPARSE_FETCH_ENT(l, item); SPARSE_FETCH_Q(l); ATT_WAIT_BAR(); }
    while (item < total) {
        const int b = l >> 7, kvh = (l >> 5) & 3, n = l & 31;
        const int t = (int)(ent >> 3), h = 2 * kvh + (int)((ent >> 2) & 1u), slot = (int)(ent & 3u);
        const unsigned mrow = (unsigned)(b * SEQ + t);
        glds_half(F, b, kvh, n, 1, 1);
        AttState st; attn_init(st);
        const int qpos = t - n * BLK;
        const LAS float* BT = (const LAS float*)(F.lds + BT_OFF);
        const float cb = BT[h * 128 + 127];
        const bool far = __all(qpos - 255 >= 127);
        if (far) {
#pragma unroll 1
            for (int kt = 0; kt < 2; ++kt) attn_tile<0>(F, st, qf, kbase, vbase, kt, qpos, h * 128, cb);
        } else {
#pragma unroll 1
            for (int kt = 0; kt < 2; ++kt) attn_tile<1>(F, st, qf, kbase, vbase, kt, qpos, h * 128, cb);
        }
        ATT_WAIT_BAR();
        const int item2 = item + F.G; int l2 = 0; const bool more = item2 < total;
        if (more) { l2 = find_list(pre, item2); glds_half(F, l2 >> 7, (l2 >> 5) & 3, l2 & 31, 0, 0); SPARSE_FETCH_ENT(l2, item2); }
        if (far) {
#pragma unroll 1
            for (int kt = 2; kt < 4; ++kt) attn_tile<0>(F, st, qf, kbase, vbase, kt, qpos, h * 128, cb);
        } else {
#pragma unroll 1
            for (int kt = 2; kt < 4; ++kt) attn_tile<1>(F, st, qf, kbase, vbase, kt, qpos, h * 128, cb);
        }
        if (more) { SPARSE_FETCH_Q(l2); }
        asm volatile("s_waitcnt vmcnt(8)" ::: "memory");
        __builtin_amdgcn_s_barrier(); asm volatile("" ::: "memory");
        const float lt = st.l + __shfl_xor(st.l, 32); const float inv = 1.0f / lt;
        {
            const unsigned prow = (mrow * NH + h) * 3 + slot;
            store_row_fp8(st.o, inv, (unsigned char*)OP + (size_t)prow * HD, hi);
            if (hi == 0) ML[prow] = (f32x2){st.m, lt};
        }
        item = item2; l = l2;
    }
#undef SPARSE_FETCH_ENT
#undef SPARSE_FETCH_Q
    ATT_WAIT_BAR();
}
__device__ __forceinline__ void p_attn_own(Frame& F) {
    const bf16* QB = (const bf16*)((unsigned char*)F.out + DO_QB); bf16* OB = (bf16*)((unsigned char*)F.out + DO_QB);
    const bf16* OP = (const bf16*)(F.ws + WS_OP); const f32x2* ML = (const f32x2*)(F.ws + WS_ML);
    build_bias_table(F);
    int kbase, vbase; attn_lane_offsets(F.lane, kbase, vbase);
    const int hi = F.lane >> 5;
    for (int item = F.bid; item < BATCH * NKV * NB; item += F.G) {
        const int kvh = item % NKV, j = (item / NKV) % NB, b = item / (NKV * NB);
        glds_half(F, b, kvh, j, 0, 0); glds_half(F, b, kvh, j, 1, 1);
        ATT_WAIT_BAR();
#pragma unroll 1
        for (int task = 0; task < 2; ++task) {
            const int h = 2 * kvh + task, qg = task ? 7 - F.wave : F.wave;
            const int qpos = qg * 32 + (F.lane & 31), t = j * BLK + qpos;
            const unsigned mrow = (unsigned)(b * SEQ + t);
            bf16x8 qf[8];
#pragma unroll
            for (int ks = 0; ks < 8; ++ks) qf[ks] = *(const bf16x8*)(QB + (mrow * D + h * HD + 16 * ks + 8 * hi));
            AttState st; attn_init(st);
            const int ntile = (qg >> 1) + 1;
#pragma unroll 1
            for (int kt = 0; kt < ntile; ++kt) attn_tile<2>(F, st, qf, kbase, vbase, kt, qpos, h * 128, 0.f);
            const float lo = st.l + __shfl_xor(st.l, 32);
            const int nvalid = j < 3 ? j : 3;
            const unsigned prow = (mrow * NH + h) * 3;
            f32x2 ml[3]; float mxx = st.m;
#pragma unroll
            for (int s = 0; s < 3; ++s) { ml[s] = (f32x2){-1.0e30f, 0.f}; if (s < nvalid) { ml[s] = ML[prow + s]; mxx = fmaxf(mxx, ml[s].x); } }
            const float co = fexp2(st.m - mxx); float den = co * lo;
#pragma unroll
            for (int db = 0; db < 4; ++db) st.o[db] = st.o[db] * co;
#pragma unroll
            for (int s = 0; s < 3; ++s) if (s < nvalid) { const float cs = ml[s].y * fexp2(ml[s].x - mxx); den += cs;
                addrow_fp8(st.o, cs, (const unsigned char*)OP + (size_t)(prow + s) * HD, hi); }
            const float inv = 1.0f / den;
            bf16* ob = F.dry ? (bf16*)(F.ws + WS_LIST) + ((mrow & 8191u) * D + h * HD) : OB + (mrow * D + h * HD);
            store_row16(st.o, inv, ob, hi);
        }
        ATT_WAIT_BAR();
    }
}

__global__ void __launch_bounds__(512, 2) yoco_fwd(Args args) {
    extern __shared__ __attribute__((aligned(16))) unsigned char lds_raw[];
    Frame F;
    F.lds = (LAS unsigned char*)lds_raw;
    F.tid = threadIdx.x; F.lane = F.tid & 63; F.wave = __builtin_amdgcn_readfirstlane(F.tid >> 6); F.G = gridDim.x;
    F.out = args.out; F.ws = args.ws; F.kp = (const CAS unsigned char*)__builtin_amdgcn_kernarg_segment_ptr();
    unsigned char* ws = args.ws;
    for (int u = F.tid; u < (LDS_BYTES - LDSCTL_OFF) / 4; u += 512) ((LAS unsigned*)(F.lds + LDSCTL_OFF))[u] = 0u;
    __syncthreads();
    volatile LAS unsigned* MISC = (volatile LAS unsigned*)(F.lds + MISC_OFF);
    XcdBarrier bar; bar.bar = (unsigned*)(ws + WS_CTL) + CW_BAR; bar.x = 0; bar.st = nullptr;
    const int lo = args.ph_lo, hi = args.ph_hi;
    if (hi - lo > 1) bar = xcd_barrier_post((unsigned*)(ws + WS_CTL) + CW_BAR, MISC + 8);
#ifndef PHASE_MASK
#define PHASE_MASK 0xffffffffu
#endif
#define EN(k) (((PHASE_MASK) >> (k)) & 1u)
    for (int pid = lo; pid < hi; ++pid) {
      const int nrep = 1 + (int)((REPEAT_SET >> pid) & 1u);
      for (int rep = 0; rep < nrep; ++rep) {
        fresh_ids(F); ws = F.ws; F.dry = rep;
        const int cid = F.bid;
        float* MOD0 = (float*)(ws + WS_MOD0); float* MOD1 = (float*)(ws + WS_MOD1); float* KVMOD = (float*)(ws + WS_KVMOD);
        switch (pid) {
        case 0: if (EN(0)) { p_modgemv(F); } break;
        case 1: if (EN(1)) { p_weights(F, 0, F.bid * 8 + F.wave, F.G * 8); norm_mod_rows<1, false>(F, ARG_IN(F, I_X), ARG_IN(F, I_NMIX), MOD0, MOD0 + D, 6 * D, (bf16*)(ws + WS_H_L0), nullptr, nullptr, nullptr, 0, nullptr); } break;
        case 2: if (EN(2)) { pg8::Gemm g{(const bf16*)(ws + WS_H_L0), (const bf16*)(ws + WS_WIN), M, 2 * LW, D, D}; pg8::StaticOrder S; S.init(M, 2 * LW, F.G, cid);
                pg8::EpiInProj E{(bf16*)(ws + WS_Y), (bf16*)(ws + WS_XB)};
                pg8::gemm_phase<pg8::EpiInProj, pg8::StaticOrder, true>(F.lds + RING_OFF, g, S, E); p_weights_bubble(F, 1); } break;
        case 3: if (EN(3)) p_conv(F); break;
        case 4: if (EN(4)) { pg8::Gemm g{(const bf16*)(ws + WS_XC), (const bf16*)(ws + WS_WG), M, 2 * LW, LB, LW}; pg8::GatesOrder S{F.G, cid};
                pg8::EpiGates E{(const bf16*)(ws + WS_XC), (bf16*)(ws + WS_XB), (bf16*)(ws + WS_BB), ARG_IN(F, I_BGATES), ARG_IN(F, I_BGATES) + LW, (const float*)(ws + WS_C8)};
                pg8::gemm_phase<pg8::EpiGates, pg8::GatesOrder, true>(F.lds + RING_OFF, g, S, E); p_weights_bubble(F, 2); } break;
        case 5: if (EN(5)) p_scan1(F); break;
        case 6: if (EN(6)) p_scan_carry(F); break;
        case 7: if (EN(6)) p_scan2(F); break;
        case 8: case 18: if (EN(7)) { const int layer = pid == 18; float* MOD = layer ? MOD1 : MOD0;
                pg8::Gemm g; pg8::EpiResid E; pg8::StaticOrder S; S.init(M, D, F.G, cid);
                if (layer == 0) { g = pg8::Gemm{(const bf16*)(ws + WS_Y), (const bf16*)(ws + WS_WOUT), M, D, LW, LW}; E = pg8::EpiResid{ARG_IN(F, I_X), ws + WS_XS, MOD + 2 * D, 6 * D, 0, 1}; }
                else { g = pg8::Gemm{(const bf16*)((unsigned char*)F.out + DO_QB), (const bf16*)(ws + WS_WO), M, D, D, D}; E = pg8::EpiResid{ws + WS_XS, ws + WS_XS, MOD + 2 * D, 6 * D, 1, 1}; }
                pg8::gemm_phase<pg8::EpiResid, pg8::StaticOrder, true>(F.lds + RING_OFF, g, S, E); } break;
        case 9: case 19: if (EN(8)) { const int layer = pid == 19; float* MOD = layer ? MOD1 : MOD0;
                norm_mod_rows<1, true>(F, ws + WS_XS, ARG_IN(F, I_NFFN) + layer * D, MOD + 3 * D, MOD + 4 * D, 6 * D, (bf16*)(ws + (layer ? WS_H_F1 : WS_H_F0)), nullptr, nullptr, nullptr, 0, nullptr); } break;
        case 10: case 20: if (EN(9)) { const int layer = pid == 20;
                pg8::Gemm g{(const bf16*)(ws + (layer ? WS_H_F1 : WS_H_F0)), (const bf16*)(ws + (layer ? WS_WGU1 : WS_WGU0)), M, 2 * FF, D, D}; pg8::StaticOrder S; S.init(M, 2 * FF, F.G, cid);
                pg8::EpiSwiGLU E{(bf16*)(ws + (layer ? WS_HF1 : WS_HF0))};
                pg8::gemm_phase<pg8::EpiSwiGLU, pg8::StaticOrder, true>(F.lds + RING_OFF, g, S, E); } break;
        case 11: case 21: if (EN(10)) { const int layer = pid == 21; float* MOD = layer ? MOD1 : MOD0;
                pg8::Gemm g{(const bf16*)(ws + (layer ? WS_HF1 : WS_HF0)), (const bf16*)(ws + (layer ? WS_WD1 : WS_WD0)), M, D, FF, FF}; pg8::StaticOrder S; S.init(M, D, F.G, cid);
                pg8::EpiResid E{ws + WS_XS, layer ? (void*)F.out : (void*)(ws + WS_XS), MOD + 5 * D, 6 * D, 1, layer ? 0 : 1};
                pg8::gemm_phase<pg8::EpiResid, pg8::StaticOrder, true>(F.lds + RING_OFF, g, S, E); } break;
        case 12: if (EN(11)) norm_mod_rows<2, true>(F, ws + WS_XS, ARG_IN(F, I_KVNORM), KVMOD, KVMOD + D, 2 * D, (bf16*)(ws + WS_HKV), ARG_IN(F, I_NMIX) + D, MOD1, MOD1 + D, 6 * D, (bf16*)(ws + WS_H_L1)); break;
        case 13: if (EN(12)) {
                for (int g3 = 0; g3 < 3; ++g3) {
                    pg8::Gemm g; pg8::EpiPlain E; pg8::StaticOrder S;
                    if (g3 == 0) { g = pg8::Gemm{(const bf16*)(ws + WS_HKV), (const bf16*)(ws + WS_WKV), M, NKV * HD, D, D}; E = pg8::EpiPlain{(bf16*)((unsigned char*)F.out + DO_KB), NKV * HD, 1.0f}; S.init(M, NKV * HD, F.G, cid); }
                    else if (g3 == 1) { g = pg8::Gemm{(const bf16*)(ws + WS_WKV) + (size_t)(NKV * HD) * D, (const bf16*)(ws + WS_HKV), NKV * HD, M, D, D}; E = pg8::EpiPlain{(bf16*)((unsigned char*)F.out + DO_VT), M, 1.0f};
                        S.init(NKV * HD, M, F.G, F.G >= 256 ? (cid + 128) % F.G : cid); }
                    else { g = pg8::Gemm{(const bf16*)(ws + WS_H_L1), (const bf16*)(ws + WS_WQ), M, D, D, D}; E = pg8::EpiPlain{(bf16*)((unsigned char*)F.out + DO_QB), D, 0.08838834764831845f * LOG2E}; S.init(M, D, F.G, cid); }
                    pg8::gemm_phase<pg8::EpiPlain, pg8::StaticOrder, true>(F.lds + RING_OFF, g, S, E);
                } } break;
        case 14: if (EN(13)) p_kmean(F); break;
        case 15: if (EN(14)) p_gate(F); break;
        case 16: if (EN(15)) p_attn_sparse(F); break;
        case 17: if (EN(16)) p_attn_own(F); break;
        default: if (EN(22)) final_norm_rows(F, F.out, F.dry ? (float*)(ws + ACT) : F.out, ARG_IN(F, I_FNORM)); break;
        }
        if (pid + 1 < hi || rep + 1 < nrep) { bar.bar = (unsigned*)(ws + WS_CTL) + CW_BAR; xcd_barrier(bar); }
      }
    }
}
constexpr int N_PHASES = 23;

extern "C" void kernel_launch(void* const* d_in, const int* in_sizes, int n_in, void* d_out, int out_size, void* d_ws, size_t ws_size, hipStream_t stream) {
    static int grid = 0;
    if (grid == 0) {
        if (n_in != 24 || out_size != M * D || ws_size < WS_END) { fprintf(stderr, "kernel_launch: unexpected shapes (n_in %d out %d ws %zu)\n", n_in, out_size, ws_size); grid = -1; return; }
        int dev = 0, cus = 0;
        if (hipGetDevice(&dev) != hipSuccess || hipDeviceGetAttribute(&cus, hipDeviceAttributeMultiprocessorCount, dev) != hipSuccess) { grid = -1; return; }
        if (hipFuncSetAttribute((const void*)yoco_fwd, hipFuncAttributeMaxDynamicSharedMemorySize, LDS_BYTES) != hipSuccess) { fprintf(stderr, "kernel_launch: hipFuncSetAttribute failed\n"); grid = -1; return; }
        (void)hipGetLastError();
        grid = cus;
    }
    if (grid < 0) return;
    if (hipMemsetAsync((char*)d_ws + WS_CTL, 0, CTL_ZERO_BYTES, stream) != hipSuccess) return;
    Args a{};
    for (int i = 0; i < 24; ++i) a.in[i] = (const float*)d_in[i];
    a.out = (float*)d_out; a.ws = (unsigned char*)d_ws;
#if MK_N_LAUNCHES == 1
    a.ph_lo = 0; a.ph_hi = N_PHASES;
    hipLaunchKernelGGL(yoco_fwd, dim3(grid), dim3(512), LDS_BYTES, stream, a);
#else
    for (int p = 0; p < N_PHASES; ++p) { a.ph_lo = p; a.ph_hi = p + 1; hipLaunchKernelGGL(yoco_fwd, dim3(grid), dim3(512), LDS_BYTES, stream, a); }
#endif
}
```

```cpp
#include <hip/hip_runtime.h>
#include <cstdio>
#include <cstdint>
#include <cstddef>

#ifndef MK_N_LAUNCHES
#define MK_N_LAUNCHES 1
#endif

#define DRY_VARIANT 2
#define REPEAT_SET 0x0u
#define GAS __attribute__((address_space(1)))
#define LAS __attribute__((address_space(3)))
typedef unsigned short bf16;
typedef short bf16x8 __attribute__((ext_vector_type(8)));
typedef float f32x2 __attribute__((ext_vector_type(2)));
typedef float f32x4 __attribute__((ext_vector_type(4)));
typedef float f32x16 __attribute__((ext_vector_type(16)));
typedef unsigned u32x2 __attribute__((ext_vector_type(2)));
typedef unsigned u32x4 __attribute__((ext_vector_type(4)));
typedef __bf16 bf16x2_t __attribute__((ext_vector_type(2)));
typedef GAS unsigned gu32;

__device__ __forceinline__ unsigned pk2(float lo, float hi) { f32x2 v = {lo, hi}; return __builtin_bit_cast(unsigned, __builtin_convertvector(v, bf16x2_t)); }
__device__ __forceinline__ float bflo(unsigned u) { return __uint_as_float(u << 16); }
__device__ __forceinline__ float bfhi(unsigned u) { return __uint_as_float(u & 0xffff0000u); }
__device__ __forceinline__ void unpack8(const u32x4 v, float (&x)[8]) { x[0] = bflo(v.x); x[1] = bfhi(v.x); x[2] = bflo(v.y); x[3] = bfhi(v.y); x[4] = bflo(v.z); x[5] = bfhi(v.z); x[6] = bflo(v.w); x[7] = bfhi(v.w); }
__device__ __forceinline__ float fexp2(float x) { return __builtin_amdgcn_exp2f(x); }
__device__ __forceinline__ float frcp(float x) { return __builtin_amdgcn_rcpf(x); }
#define LOG2E 1.4426950408889634f

constexpr int BATCH = 2, SEQ = 8192, D = 1024, M = BATCH * SEQ;
constexpr int LW = 1280, LH = 5, LB = 256;
constexpr int FF = 2816;
constexpr int NH = 8, NKV = 4, HD = 128, BLK = 256, NB = SEQ / BLK;
constexpr float RMS_EPS = 1e-6f;

namespace pg8 {
constexpr int BM = 256, BK = 64, HALF = 128, HTB = HALF * BK * 2, STAGE_BYTES = 8 * HTB, NXCD = 8, WGM = 8;
__host__ __device__ __forceinline__ int lds_byte(int r, int c) { const int st = (r >> 4) * 2 + (c >> 5), rr = r & 15, cc = c & 31, ob = rr * 64 + cc * 2; return st * 1024 + (ob ^ (((ob >> 9) & 1) << 5)); }
__host__ __device__ __forceinline__ void stage_rc(int b, int& R, int& C) { const int st = b / 1024, sb = b % 1024, swz = sb ^ (((sb >> 9) & 1) << 5); R = (st >> 1) * 16 + swz / 64; C = (st & 1) * 32 + (swz % 64) / 2; }
__host__ __device__ __forceinline__ int perm32(int rho) { const int n = rho >> 4, i = rho & 15; return 8 * (i >> 2) + 4 * n + (i & 3); }

struct Unit { int pm, pn, acol; };
struct Gemm { const bf16* A; const bf16* Bt; int M, N, K, lda; };

struct StaticOrder {
    int nM, nN, nwg, G, c;
    __device__ void init(int M_, int N_, int G_, int c_) { nM = M_ / BM; nN = N_ / BM; nwg = nM * nN; G = G_; c = c_; }
    __device__ bool next(int i, Unit& u) const {
        const long L = (long)i * G + c; if (L >= nwg) return false;
        int wgid = (int)L; { const int q = nwg / NXCD, r = nwg % NXCD, xcd = wgid % NXCD, off = wgid / NXCD; wgid = (xcd < r ? xcd * (q + 1) : r * (q + 1) + (xcd - r) * q) + off; }
        const int nig = WGM * nN, gid = wgid / nig, fm = gid * WGM, gsz = (nM - fm) < WGM ? (nM - fm) : WGM;
        u.pm = fm + ((wgid % nig) % gsz); u.pn = (wgid % nig) / gsz; u.acol = 0; return true;
    }
};
struct GatesOrder {
    int G, c;
    __device__ bool next(int i, Unit& u) const { const int L = i * G + c; if (L >= 640) return false; u.pm = L / 10; u.pn = L - 10 * u.pm; u.acol = (u.pn >> 1) * 256; return true; }
};

template <class Epi, class Sched, bool ALIGN_EPI>
__device__ __forceinline__ void gemm_phase(LAS unsigned char* lds, const Gemm g, const Sched& S, const Epi& E) {
    int tid_ = threadIdx.x; asm volatile("" : "+v"(tid_));
    const int tid = tid_, wid = __builtin_amdgcn_readfirstlane(tid >> 6), lane = tid & 63, wr = wid >> 2, wc = wid & 3, fr = lane & 15, fq = lane >> 4;
    int K_ = g.K, lda_ = g.lda; asm volatile("" : "+s"(K_), "+s"(lda_));
    const int K = K_, nt = K / BK, lda = lda_;
    unsigned voffA[2], voffB[2];
#pragma unroll
    for (int i = 0; i < 2; ++i) { int R, C; stage_rc(tid * 16 + i * 8192, R, C); const int Rb = Epi::PERM ? ((R & ~31) + perm32(R & 31)) : R;
        voffA[i] = (unsigned)(R * lda + C) * 2u; voffB[i] = (unsigned)(Rb * K + C) * 2u; }
    const size_t kstep = (size_t)(BK * 2);
    const size_t hsA = (size_t)HALF * lda * 2, hsB = (size_t)HALF * K * 2;
    const size_t tsA = 2 * hsA, tsB = 2 * hsB;
    const unsigned ldsw = (unsigned)wid * 1024u;
    const int aoff = lds_byte(wr * 64 + fr, fq * 8), boff = lds_byte(wc * 32 + fr, fq * 8);
#define PG8_SA(b, h) (((b) * 2 + (h)) * HTB)
#define PG8_SB(b, h) ((4 + (b) * 2 + (h)) * HTB)
#define PG8_STAGE(bufoff, gbase, voff) do { _Pragma("unroll") for (int _i = 0; _i < 2; ++_i) \
        __builtin_amdgcn_global_load_lds((const unsigned*)((const char*)(gbase) + (voff)[_i]), (LAS unsigned*)(lds + (bufoff) + ldsw + _i * 8192), 16, 0, 0); } while (0)
#define PG8_LDA(dst, b, h) do { _Pragma("unroll") for (int m = 0; m < 4; ++m) _Pragma("unroll") for (int k = 0; k < 2; ++k) dst[m][k] = *(const LAS bf16x8*)(lds + PG8_SA(b, h) + aoff + m * 2048 + k * 1024); } while (0)
#define PG8_LDB(dst, b, h) do { _Pragma("unroll") for (int n = 0; n < 2; ++n) _Pragma("unroll") for (int k = 0; k < 2; ++k) dst[n][k] = *(const LAS bf16x8*)(lds + PG8_SB(b, h) + boff + n * 2048 + k * 1024); } while (0)
#define PG8_MMA(ai, bj, At, Bt) do { __builtin_amdgcn_s_setprio(1); _Pragma("unroll") for (int m = 0; m < 4; ++m) _Pragma("unroll") for (int n = 0; n < 2; ++n) _Pragma("unroll") for (int k = 0; k < 2; ++k) \
        acc[ai][bj][m][n] = __builtin_amdgcn_mfma_f32_16x16x32_bf16(Bt[n][k], At[m][k], acc[ai][bj][m][n], 0, 0, 0); __builtin_amdgcn_s_setprio(0); } while (0)
#define PG8_WAIT_V(n) asm volatile("s_waitcnt vmcnt(" #n ")" ::: "memory")
#define PG8_WAIT_L(n) asm volatile("s_waitcnt lgkmcnt(" #n ")" ::: "memory")
#define PG8_BAR __builtin_amdgcn_s_barrier()
#define PG8_SCHED __builtin_amdgcn_sched_barrier(0)
    Unit cur, nxt; int ui = 0;
    if (!S.next(0, cur)) return;
    f32x4 acc[2][2][4][2];
#pragma unroll
    for (int a = 0; a < 2; ++a)
#pragma unroll
        for (int b = 0; b < 2; ++b)
#pragma unroll
            for (int m = 0; m < 4; ++m)
#pragma unroll
                for (int n = 0; n < 2; ++n) acc[a][b][m][n] = (f32x4){0.f, 0.f, 0.f, 0.f};
    bf16x8 At[4][2], B0[2][2], B1[2][2];
    const char* cA = (const char*)g.A + (size_t)cur.pm * tsA + (size_t)cur.acol * 2; const char* cB = (const char*)g.Bt + (size_t)cur.pn * tsB;
    PG8_STAGE(PG8_SB(0, 0), cB, voffB); PG8_STAGE(PG8_SB(0, 1), cB + hsB, voffB); PG8_STAGE(PG8_SA(0, 0), cA, voffA); PG8_STAGE(PG8_SA(0, 1), cA + hsA, voffA);
    if (wr == 1) PG8_BAR;
    PG8_WAIT_V(2); PG8_BAR;
    PG8_STAGE(PG8_SB(1, 0), cB + kstep, voffB); PG8_STAGE(PG8_SA(1, 0), cA + kstep, voffA); PG8_STAGE(PG8_SB(1, 1), cB + hsB + kstep, voffB);
    PG8_WAIT_V(6); PG8_BAR;
    for (;;) {
        const bool has_next = S.next(ui + 1, nxt);
        const char* nA = has_next ? (const char*)g.A + (size_t)nxt.pm * tsA + (size_t)nxt.acol * 2 : cA; const char* nB = has_next ? (const char*)g.Bt + (size_t)nxt.pn * tsB : cB;
        for (int t = 0; t < nt; t += 2) {
            const bool last = (t == nt - 2);
            const char* a1 = cA + (size_t)(t + 1) * kstep;
            const char* a2 = last ? nA : cA + (size_t)(t + 2) * kstep; const char* b2 = last ? nB : cB + (size_t)(t + 2) * kstep;
            const char* a3 = a2 + kstep; const char* b3 = b2 + kstep;
            PG8_LDB(B0, 0, 0); PG8_LDB(B1, 0, 1); PG8_SCHED; PG8_LDA(At, 0, 0); PG8_STAGE(PG8_SA(1, 1), a1 + hsA, voffA);
            PG8_WAIT_V(8); PG8_WAIT_L(0); PG8_BAR; PG8_MMA(0, 0, At, B0); PG8_MMA(0, 1, At, B1); PG8_BAR; PG8_SCHED;
            PG8_LDA(At, 0, 1); PG8_STAGE(PG8_SB(0, 0), b2, voffB); PG8_STAGE(PG8_SB(0, 1), b2 + hsB, voffB); PG8_STAGE(PG8_SA(0, 0), a2, voffA);
            PG8_WAIT_V(8); PG8_WAIT_L(0); PG8_BAR; PG8_MMA(1, 0, At, B0); PG8_MMA(1, 1, At, B1); PG8_BAR; PG8_SCHED;
            PG8_LDB(B0, 1, 0); PG8_LDB(B1, 1, 1); PG8_SCHED; PG8_LDA(At, 1, 0); PG8_STAGE(PG8_SA(0, 1), a2 + hsA, voffA);
            PG8_WAIT_V(8); PG8_WAIT_L(0); PG8_BAR; PG8_MMA(0, 0, At, B0); PG8_MMA(0, 1, At, B1); PG8_BAR; PG8_SCHED;
            PG8_LDA(At, 1, 1); PG8_STAGE(PG8_SB(1, 0), b3, voffB); PG8_STAGE(PG8_SB(1, 1), b3 + hsB, voffB); PG8_STAGE(PG8_SA(1, 0), a3, voffA);
            PG8_WAIT_V(8); PG8_WAIT_L(0); PG8_BAR; PG8_MMA(1, 0, At, B0); PG8_MMA(1, 1, At, B1); PG8_BAR; PG8_SCHED;
        }
        if constexpr (ALIGN_EPI) { if (wr == 0) PG8_BAR; }
        E(acc, cur, wr, wc, fr, fq);
        if (!has_next) break;
#pragma unroll
        for (int a = 0; a < 2; ++a)
#pragma unroll
            for (int b = 0; b < 2; ++b)
#pragma unroll
                for (int m = 0; m < 4; ++m)
#pragma unroll
                    for (int n = 0; n < 2; ++n) acc[a][b][m][n] = (f32x4){0.f, 0.f, 0.f, 0.f};
        cur = nxt; cA = nA; cB = nB; ++ui;
        if constexpr (ALIGN_EPI) { if (wr == 1) PG8_BAR; }
    }
    PG8_WAIT_V(0);
    if constexpr (!ALIGN_EPI) { if (wr == 0) PG8_BAR; }
    PG8_BAR;
#undef PG8_SA
#undef PG8_SB
#undef PG8_STAGE
#undef PG8_LDA
#undef PG8_LDB
#undef PG8_MMA
#undef PG8_WAIT_V
#undef PG8_WAIT_L
#undef PG8_BAR
#undef PG8_SCHED
}

typedef f32x4 AccT[2][2][4][2];

struct EpiPlain {
    static constexpr bool PERM = true;
    bf16* O; int ldc; float scale;
    __device__ __forceinline__ void operator()(const AccT& acc, const Unit& u, int wr, int wc, int fr, int fq) const {
        const int row0 = u.pm * BM + wr * 64 + fr, col0 = u.pn * BM + wc * 32 + 8 * fq;
#pragma unroll
        for (int ai = 0; ai < 2; ++ai)
#pragma unroll
            for (int m = 0; m < 4; ++m) { bf16* rowp = O + (size_t)(row0 + ai * HALF + m * 16) * ldc + col0;
#pragma unroll
                for (int bj = 0; bj < 2; ++bj) { const f32x4 v0 = acc[ai][bj][m][0] * scale, v1 = acc[ai][bj][m][1] * scale;
                    u32x4 w; w.x = pk2(v0[0], v0[1]); w.y = pk2(v0[2], v0[3]); w.z = pk2(v1[0], v1[1]); w.w = pk2(v1[2], v1[3]);
                    *(u32x4*)(rowp + bj * HALF) = w; } }
    }
};
__device__ __forceinline__ float gelu_tanh(float v) {
    const float u2 = v * (1.5957691216057308f + 0.07135481627260025f * v * v);
    return v * frcp(1.0f + fexp2(-u2 * LOG2E));
}
struct EpiInProj {
    static constexpr bool PERM = true;
    bf16* Y; bf16* XB;
    __device__ __forceinline__ void operator()(const AccT& acc, const Unit& u, int wr, int wc, int fr, int fq) const {
        const int row0 = u.pm * BM + wr * 64 + fr; int colt = u.pn * BM; const bool isy = colt < LW; bf16* base = isy ? Y : XB; if (!isy) colt -= LW;
        const int col0 = colt + wc * 32 + 8 * fq;
#pragma unroll
        for (int ai = 0; ai < 2; ++ai)
#pragma unroll
            for (int m = 0; m < 4; ++m) { bf16* rowp = base + (size_t)(row0 + ai * HALF + m * 16) * LW + col0;
#pragma unroll
                for (int bj = 0; bj < 2; ++bj) { f32x4 v0 = acc[ai][bj][m][0], v1 = acc[ai][bj][m][1];
                    if (isy) {
#pragma unroll
                        for (int j = 0; j < 4; ++j) { v0[j] = gelu_tanh(v0[j]); v1[j] = gelu_tanh(v1[j]); } }
                    u32x4 w; w.x = pk2(v0[0], v0[1]); w.y = pk2(v0[2], v0[3]); w.z = pk2(v1[0], v1[1]); w.w = pk2(v1[2], v1[3]);
                    *(u32x4*)(rowp + bj * HALF) = w; } }
    }
};
struct EpiGates {
    static constexpr bool PERM = true;
    const bf16* XC; bf16* LA; bf16* BBo; const float* bgr; const float* bgi; const float* c8;
    __device__ __forceinline__ void operator()(const AccT& acc, const Unit& u, int wr, int wc, int fr, int fq) const {
        const int row0 = u.pm * BM + wr * 64 + fr; const int ch0 = (u.pn >> 1) * 256 + (u.pn & 1) * 128 + wc * 32 + 8 * fq;
        float br[8], bi[8], cc[8];
#pragma unroll
        for (int j = 0; j < 8; ++j) { br[j] = -LOG2E * bgr[ch0 + j]; bi[j] = -LOG2E * bgi[ch0 + j]; cc[j] = c8[ch0 + j]; }
#pragma unroll
        for (int ai = 0; ai < 2; ++ai)
#pragma unroll
            for (int m = 0; m < 4; ++m) { const size_t off = (size_t)(row0 + ai * HALF + m * 16) * LW + ch0;
                float xc[8]; unpack8(*(const u32x4*)(XC + off), xc);
                float la[8], bb[8];
#pragma unroll
                for (int n = 0; n < 2; ++n)
#pragma unroll
                    for (int j = 0; j < 4; ++j) { const int e = 4 * n + j;
                        const float r = frcp(1.0f + fexp2(acc[ai][0][m][n][j] * (-LOG2E) + br[e])), ig = frcp(1.0f + fexp2(acc[ai][1][m][n][j] * (-LOG2E) + bi[e]));
                        const float l = -cc[e] * r; const float a2 = fexp2((2.0f * LOG2E) * l);
                        la[e] = l; bb[e] = __builtin_sqrtf(1.0f - a2) * (ig * xc[e]); }
                u32x4 w; w.x = pk2(la[0], la[1]); w.y = pk2(la[2], la[3]); w.z = pk2(la[4], la[5]); w.w = pk2(la[6], la[7]);
                *(u32x4*)(LA + off) = w;
                w.x = pk2(bb[0], bb[1]); w.y = pk2(bb[2], bb[3]); w.z = pk2(bb[4], bb[5]); w.w = pk2(bb[6], bb[7]);
                *(u32x4*)(BBo + off) = w;
                asm volatile("" ::: "memory"); }
    }
};
struct EpiSwiGLU {
    static constexpr bool PERM = true;
    bf16* HF;
    __device__ __forceinline__ void operator()(const AccT& acc, const Unit& u, int wr, int wc, int fr, int fq) const {
        const int row0 = u.pm * BM + wr * 64 + fr, col0 = u.pn * HALF + wc * 32 + 8 * fq;
#pragma unroll
        for (int ai = 0; ai < 2; ++ai)
#pragma unroll
            for (int m = 0; m < 4; ++m) { float o[8];
#pragma unroll
                for (int n = 0; n < 2; ++n)
#pragma unroll
                    for (int j = 0; j < 4; ++j) { const float gt = acc[ai][0][m][n][j], up = acc[ai][1][m][n][j]; o[4 * n + j] = gt * frcp(1.0f + fexp2(-gt * LOG2E)) * up; }
                u32x4 w; w.x = pk2(o[0], o[1]); w.y = pk2(o[2], o[3]); w.z = pk2(o[4], o[5]); w.w = pk2(o[6], o[7]);
                *(u32x4*)(HF + (size_t)(row0 + ai * HALF + m * 16) * FF + col0) = w; }
    }
};
struct EpiResid {
    static constexpr bool PERM = true;
    const void* resid; void* out; const float* gv; int gstride; int rbf, obf;
    __device__ __forceinline__ void operator()(const AccT& acc, const Unit& u, int wr, int wc, int fr, int fq) const {
        const int row0 = u.pm * BM + wr * 64 + fr, col0 = u.pn * BM + wc * 32 + 8 * fq; const float* gp = gv + (size_t)(u.pm >> 5) * gstride + col0;
        f32x4 gg[2][2];
#pragma unroll
        for (int bj = 0; bj < 2; ++bj)
#pragma unroll
            for (int n = 0; n < 2; ++n) gg[bj][n] = *(const f32x4*)(gp + bj * HALF + 4 * n);
#pragma unroll
        for (int ai = 0; ai < 2; ++ai)
#pragma unroll
            for (int m = 0; m < 4; ++m) { const size_t off = (size_t)(row0 + ai * HALF + m * 16) * D + col0;
#pragma unroll
                for (int bj = 0; bj < 2; ++bj) { const size_t o = off + bj * HALF; f32x4 r0, r1;
                    if (rbf) { const u32x4 w = *(const u32x4*)((const bf16*)resid + o); r0 = (f32x4){bflo(w.x), bfhi(w.x), bflo(w.y), bfhi(w.y)}; r1 = (f32x4){bflo(w.z), bfhi(w.z), bflo(w.w), bfhi(w.w)}; }
                    else { r0 = __builtin_nontemporal_load((const f32x4*)((const float*)resid + o)); r1 = __builtin_nontemporal_load((const f32x4*)((const float*)resid + o + 4)); }
                    const f32x4 x0 = r0 + gg[bj][0] * acc[ai][bj][m][0], x1 = r1 + gg[bj][1] * acc[ai][bj][m][1];
                    if (obf) { u32x4 w; w.x = pk2(x0[0], x0[1]); w.y = pk2(x0[2], x0[3]); w.z = pk2(x1[0], x1[1]); w.w = pk2(x1[2], x1[3]); *(u32x4*)((bf16*)out + o) = w; }
                    else { *(f32x4*)((float*)out + o) = x0; *(f32x4*)((float*)out + o + 4) = x1; } } }
    }
};
}

constexpr size_t MiB = 1u << 20;
constexpr size_t WS_CTL = 0, CTL_ZERO_BYTES = 1 * MiB;
constexpr int CW_TMO = 0, CW_BAR = 4096, CW_LCNT = 16384;
constexpr size_t WS_MOD0 = 1 * MiB, WS_MOD1 = WS_MOD0 + 65536, WS_KVMOD = WS_MOD1 + 65536, WS_C8 = WS_KVMOD + 32768, WS_KM = WS_C8 + 8192;
constexpr size_t WS_SA = 250 * MiB, WS_SB = 253 * MiB;
constexpr size_t WS_ML = 5 * MiB;
constexpr size_t WS_WIN = 8 * MiB, WS_WG = 13 * MiB, WS_WOUT = 15 * MiB, WS_WKV = 18 * MiB, WS_WQ = 20 * MiB, WS_WO = 22 * MiB;
constexpr size_t WS_WGU0 = 24 * MiB, WS_WGU1 = 35 * MiB, WS_WD0 = 46 * MiB, WS_WD1 = 52 * MiB;
constexpr size_t ACT = 58 * MiB;
constexpr size_t WS_H_L0 = ACT, WS_Y = ACT + 32 * MiB, WS_XB = ACT + 72 * MiB, WS_XC = ACT + 112 * MiB, WS_BB = ACT + 152 * MiB;
constexpr size_t WS_H_F0 = ACT, WS_HF0 = ACT + 32 * MiB;
constexpr size_t WS_XS = 224 * MiB;
constexpr size_t DO_QB = 0, DO_KB = 32 * MiB, DO_VT = 48 * MiB;
constexpr size_t WS_LIST = ACT, WS_OP = ACT + 16 * MiB;
constexpr size_t WS_HKV = ACT + 16 * MiB, WS_H_L1 = ACT + 48 * MiB;
constexpr size_t WS_H_F1 = ACT + 112 * MiB, WS_HF1 = ACT;
constexpr size_t WS_END = 256 * MiB;
constexpr int LIST_CAP = 16384;

constexpr int RING_OFF = 0, RING_BYTES = 131072;
constexpr int LDSCTL_OFF = RING_BYTES, MISC_OFF = LDSCTL_OFF + 320;
constexpr int BT_OFF = LDSCTL_OFF + 512;
constexpr int PRE_OFF = BT_OFF + 4096;
constexpr int LDS_BYTES = 147456;
static_assert(PRE_OFF + 2048 <= LDS_BYTES, "LDS map");

#define RLX_AGENT __ATOMIC_RELAXED, __HIP_MEMORY_SCOPE_AGENT
#define LDS_WAIT() asm volatile("s_waitcnt lgkmcnt(0)" ::: "memory")

#define XB_TMO      128
#define XB_XCNT(j)  (256  + 64 * (j))
#define XB_XSUB(j)  (1280 + 64 * (j))
#define XB_XGEN(j)  (2304 + 64 * (j))
#define XB_TOP      3328
#define XB_TOPGEN   3392
#define XCD_BAR_WORDS 3456
#define XB_SPIN_CAP (1u << 18)
__device__ __forceinline__ unsigned xb_ld(unsigned* p)              { return __hip_atomic_load(p, __ATOMIC_RELAXED, __HIP_MEMORY_SCOPE_AGENT); }
__device__ __forceinline__ unsigned xb_add(unsigned* p, unsigned v) { return __hip_atomic_fetch_add(p, v, __ATOMIC_RELAXED, __HIP_MEMORY_SCOPE_AGENT); }
__device__ __forceinline__ unsigned xb_xcc_id() { return (unsigned)__builtin_amdgcn_s_getreg((3 << 11) | 20) & 0xFu; }
#define XB_SPIN(cond, bar) do { unsigned _sp = 0; while (cond) { __builtin_amdgcn_s_sleep(1); \
    if ((++_sp & 255u) == 0u) { if (xb_ld(&(bar)[XB_TMO])) break; if (_sp > XB_SPIN_CAP) { atomicAdd(&(bar)[XB_TMO], 1u); break; } } } } while (0)
struct XcdBarrier { unsigned* bar; unsigned x; volatile LAS unsigned* st; };
__device__ __forceinline__ XcdBarrier xcd_barrier_post(unsigned* bar, volatile LAS unsigned* st) {
    XcdBarrier b; b.bar = bar; b.x = xb_xcc_id(); b.st = st;
    if (threadIdx.x == 0) (void)xb_add(&bar[XB_XCNT(b.x)], 1u);
    return b;
}
__device__ __forceinline__ void xcd_barrier_complete(unsigned* bar, unsigned x, unsigned& nloc, unsigned& nx) {
    const unsigned G = gridDim.x * gridDim.y * gridDim.z;
    unsigned sum, cnt, mine, sp = 0u;
    for (;;) {
        sum = 0u; cnt = 0u; mine = 0u;
#pragma nounroll
        for (unsigned j = 0; j < 16; ++j) { const unsigned c = xb_ld(&bar[XB_XCNT(j)]); sum += c; cnt += (c > 0u) ? 1u : 0u; mine = (j == x) ? c : mine; }
        if (sum == G) break;
        __builtin_amdgcn_s_sleep(1);
        if ((++sp & 255u) == 0u) { if (xb_ld(&bar[XB_TMO])) break; if (sp > XB_SPIN_CAP) { atomicAdd(&bar[XB_TMO], 1u); break; } }
    }
    nloc = mine > 0u ? mine : 1u; nx = cnt > 0u ? cnt : 1u;
}
__device__ __forceinline__ void xcd_barrier(const XcdBarrier& b) {
    asm volatile("s_waitcnt vmcnt(0)" ::: "memory");
    __syncthreads();
    int tid0_ = threadIdx.x; asm volatile("" : "+v"(tid0_));
    if (tid0_ == 0) {
        unsigned* bar = b.bar;
        __builtin_amdgcn_s_waitcnt(0);
        unsigned nloc = b.st[0], nx = b.st[1];
        if (nloc == 0u) { xcd_barrier_complete(bar, b.x, nloc, nx); b.st[0] = nloc; b.st[1] = nx; }
        const unsigned old = xb_add(&bar[XB_XSUB(b.x)], 1u);
        const unsigned gen = old / nloc;
        if (old + 1u == (gen + 1u) * nloc) {
            __builtin_amdgcn_fence(__ATOMIC_RELEASE, "agent");
            asm volatile("s_waitcnt vmcnt(0)" ::: "memory");
            const unsigned og = xb_add(&bar[XB_TOP], 1u);
            const unsigned tg = og / nx;
            if (og + 1u == (tg + 1u) * nx) xb_add(&bar[XB_TOPGEN], 1u);
            else XB_SPIN(xb_ld(&bar[XB_TOPGEN]) == tg, bar);
            __builtin_amdgcn_fence(__ATOMIC_ACQUIRE, "agent");
            xb_add(&bar[XB_XGEN(b.x)], 1u);
            asm volatile("s_waitcnt vmcnt(0)" ::: "memory");
        } else {
            XB_SPIN(xb_ld(&bar[XB_XGEN(b.x)]) == gen, bar);
            __builtin_amdgcn_fence(__ATOMIC_ACQUIRE, "agent");
            asm volatile("s_waitcnt vmcnt(0)" ::: "memory");
        }
    }
    __syncthreads();
}

struct Args { const float* in[24]; float* out; unsigned char* ws; int ph_lo, ph_hi; };
static_assert(offsetof(Args, out) == 192 && offsetof(Args, ws) == 200, "kernarg layout");
struct Frame {
    LAS unsigned char* lds;
    int tid, lane, wave, G, bid, dry;
    const __attribute__((address_space(4))) unsigned char* kp; float* out; unsigned char* ws;
};
#define CAS __attribute__((address_space(4)))
#define ARG_IN(F, i) (((const float* const CAS*)(F).kp)[(i)])
enum { I_X = 0, I_C, I_MODW, I_MODB, I_NMIX, I_NFFN, I_WIN, I_CONVW, I_CONVB, I_WGATES, I_BGATES, I_LAMBDA, I_WOUT, I_KVMODW, I_KVMODB, I_KVNORM, I_WKV, I_WQ, I_WO, I_RELB, I_FGATE, I_FUP, I_FDOWN, I_FNORM };

__device__ __forceinline__ void fresh_ids(Frame& F) {
    int t = threadIdx.x; asm volatile("" : "+v"(t)); F.tid = t; F.lane = t & 63; F.wave = __builtin_amdgcn_readfirstlane(t >> 6);
    const CAS unsigned char* kp = (const CAS unsigned char*)__builtin_amdgcn_kernarg_segment_ptr(); asm volatile("" : "+s"(kp)); F.kp = kp;
    F.out = *(float* const CAS*)(kp + 192); F.ws = *(unsigned char* const CAS*)(kp + 200);
    int g = gridDim.x; asm volatile("" : "+s"(g)); F.G = g;
    int bx = blockIdx.x; asm volatile("" : "+s"(bx)); F.bid = bx;
}
__device__ __forceinline__ float wave_sum(float v) {
#pragma unroll
    for (int o = 1; o < 64; o <<= 1) v += __shfl_xor(v, o);
    return v;
}

__device__ __forceinline__ void p_modgemv(Frame& F) {
    LAS float* cs = (LAS float*)(F.lds + RING_OFF);
    LAS float* red = cs + 2048;
    for (int i = F.tid; i < 2048; i += 512) { const float c = ARG_IN(F, I_C)[i]; cs[i] = c * frcp(1.0f + fexp2(-c * LOG2E)); }
    __syncthreads();
    for (int it = F.bid; it < 224; it += F.G) {
        const float* W; const float* bias; float* out; int N, g;
        if (it < 96) { W = ARG_IN(F, I_MODW); N = 6 * D; g = it; bias = ARG_IN(F, I_MODB); out = (float*)(F.ws + WS_MOD0); }
        else if (it < 192) { W = ARG_IN(F, I_MODW) + (size_t)D * 6 * D; N = 6 * D; g = it - 96; bias = ARG_IN(F, I_MODB) + 6 * D; out = (float*)(F.ws + WS_MOD1); }
        else { W = ARG_IN(F, I_KVMODW); N = 2 * D; g = it - 192; bias = ARG_IN(F, I_KVMODB); out = (float*)(F.ws + WS_KVMOD); }
        const int col = g * 64 + F.lane; const int k0 = 128 * F.wave;
        const float* wp = W + (size_t)k0 * N + col;
        float a0 = 0.f, a1 = 0.f;
#pragma unroll 16
        for (int j = 0; j < 128; ++j) { const float w = __builtin_nontemporal_load(wp + (size_t)j * N); a0 += cs[k0 + j] * w; a1 += cs[1024 + k0 + j] * w; }
        red[(F.wave * 2 + 0) * 64 + F.lane] = a0; red[(F.wave * 2 + 1) * 64 + F.lane] = a1;
        __syncthreads();
        if (F.tid < 128) { const int b = F.tid >> 6, l = F.tid & 63; float s = 0.f;
#pragma unroll
            for (int w = 0; w < 8; ++w) s += red[(w * 2 + b) * 64 + l];
            out[(size_t)b * N + g * 64 + l] = s + bias[g * 64 + l]; }
        __syncthreads();
    }
}
struct TItem { const float* src; bf16* dst; int N, K, k0, n0, drow0; };
__device__ __forceinline__ void ti_load(const TItem& t, float (&wv)[32], int lane) {
#pragma unroll
    for (int i = 0; i < 32; ++i) wv[i] = __builtin_nontemporal_load(t.src + (size_t)(t.k0 + 2 * i + (lane >> 5)) * t.N + t.n0 + (lane & 31));
}
__device__ __forceinline__ void ti_store(const TItem& t, const float (&wv)[32], LAS float* scr, int lane) {
#pragma unroll
    for (int i = 0; i < 32; ++i) scr[(2 * i + (lane >> 5)) * 33 + (lane & 31)] = wv[i];
    LDS_WAIT(); asm volatile("" ::: "memory");
    const int c = lane & 7;
#pragma unroll
    for (int j = 0; j < 4; ++j) { const int n = (lane >> 3) + 8 * j; const LAS float* q = scr + (8 * c) * 33 + n;
        u32x4 o; o.x = pk2(q[0 * 33], q[1 * 33]); o.y = pk2(q[2 * 33], q[3 * 33]); o.z = pk2(q[4 * 33], q[5 * 33]); o.w = pk2(q[6 * 33], q[7 * 33]);
        *(GAS u32x4*)(t.dst + (size_t)(t.drow0 + n) * t.K + t.k0 + 8 * c) = o; }
    LDS_WAIT(); asm volatile("" ::: "memory");
}
__device__ __forceinline__ TItem ti_get(Frame& F, int stage, int r) {
    unsigned char* ws = F.ws; TItem t;
    constexpr int I_IN = (D / 64) * (2 * LW / 32), I_G = LH * (LB / 64) * (2 * LB / 32), I_SQ = (D / 64) * (D / 32), I_FU = (D / 64) * (FF / 32);
    if (stage == 0) {
        if (r < I_IN) { const int nb = 2 * LW / 32; t = TItem{ARG_IN(F, I_WIN), (bf16*)(ws + WS_WIN), 2 * LW, D, 64 * (r / nb), 32 * (r % nb), 32 * (r % nb)}; return t; } r -= I_IN;
        if (r < I_G) { const int h = r / 64, rr = r % 64, n0 = 32 * (rr % 16);
            t = TItem{ARG_IN(F, I_WGATES) + (size_t)h * LB * 2 * LB, (bf16*)(ws + WS_WG), 2 * LB, LB, 64 * (rr / 16), n0, (2 * h + ((n0 % 256) / 128)) * 256 + 128 * (n0 / 256) + (n0 % 128)}; return t; } r -= I_G;
        { const int nb = D / 32; t = TItem{ARG_IN(F, I_WOUT), (bf16*)(ws + WS_WOUT), D, LW, 64 * (r / nb), 32 * (r % nb), 32 * (r % nb)}; return t; }
    }
    const int l = stage - 1;
    if (stage == 2) {
        if (r < 3 * I_SQ) { const int w = r / I_SQ, rr = r % I_SQ, nb = D / 32;
            t = TItem{w == 0 ? ARG_IN(F, I_WKV) : (w == 1 ? ARG_IN(F, I_WQ) : ARG_IN(F, I_WO)), (bf16*)(ws + (w == 0 ? WS_WKV : (w == 1 ? WS_WQ : WS_WO))), D, D, 64 * (rr / nb), 32 * (rr % nb), 32 * (rr % nb)}; return t; } r -= 3 * I_SQ;
    }
    if (r < 2 * I_FU) { const int up = r / I_FU, rr = r % I_FU, nb = FF / 32, n0 = 32 * (rr % nb);
        t = TItem{(up ? ARG_IN(F, I_FUP) : ARG_IN(F, I_FGATE)) + (size_t)l * D * FF, (bf16*)(ws + (l ? WS_WGU1 : WS_WGU0)), FF, D, 64 * (rr / nb), n0, 256 * (n0 / 128) + 128 * up + (n0 % 128)}; return t; } r -= 2 * I_FU;
    { const int nb = D / 32; t = TItem{ARG_IN(F, I_FDOWN) + (size_t)l * FF * D, (bf16*)(ws + (l ? WS_WD1 : WS_WD0)), D, FF, 64 * (r / nb), 32 * (r % nb), 32 * (r % nb)}; return t; }
}
__device__ __forceinline__ void p_weights(Frame& F, int stage, int gw, int NGW) {
    LAS float* scr = (LAS float*)(F.lds + RING_OFF + 16384 + F.wave * 12288);
    constexpr int I_IN = (D / 64) * (2 * LW / 32), I_G = LH * (LB / 64) * (2 * LB / 32), I_OUT = (LW / 64) * (D / 32), I_SQ = (D / 64) * (D / 32), I_FU = (D / 64) * (FF / 32), I_FD = (FF / 64) * (D / 32);
    const int nitems = stage == 0 ? I_IN + I_G + I_OUT : (stage == 1 ? 2 * I_FU + I_FD : 3 * I_SQ + 2 * I_FU + I_FD);
    if (stage == 0)
        for (int i = F.bid * 512 + F.tid; i < LW; i += F.G * 512) { const float x = -ARG_IN(F, I_LAMBDA)[i]; const float sp = fmaxf(x, 0.f) + log1pf(__expf(-fabsf(x))); ((float*)(F.ws + WS_C8))[i] = 8.0f * sp; }
    int it = gw; if (it >= nitems) return;
    float va[32], vb[32];
    TItem ta = ti_get(F, stage, it), tb = ta; ti_load(ta, va, F.lane);
    for (;;) {
        const int it2 = it + NGW; const bool m2 = it2 < nitems;
        if (m2) { tb = ti_get(F, stage, it2); ti_load(tb, vb, F.lane); }
        ti_store(ta, va, scr, F.lane);
        if (!m2) break;
        const int it3 = it2 + NGW; const bool m3 = it3 < nitems;
        if (m3) { ta = ti_get(F, stage, it3); ti_load(ta, va, F.lane); }
        ti_store(tb, vb, scr, F.lane);
        if (!m3) break;
        it = it3;
    }
}
__device__ __forceinline__ void p_weights_bubble(Frame& F, int stage) {
    const int G = F.G, rounds = (640 + G - 1) / G, full = 640 - (rounds - 1) * G;
    if (F.dry) return;
    if (full < G) { if (F.bid >= full) p_weights(F, stage, (F.bid - full) * 8 + F.wave, (G - full) * 8); }
    else p_weights(F, stage, F.bid * 8 + F.wave, G * 8);
}
template <int NOUT, bool XBF>
__device__ __forceinline__ void norm_mod_rows(Frame& F, const void* X, const float* g0, const float* sh0, const float* sc0, int bs0, bf16* o0,
                                              const float* g1, const float* sh1, const float* sc1, int bs1, bf16* o1) {
    const int gw = F.bid * 8 + F.wave, NGW = F.G * 8;
    for (int b = 0; b < BATCH; ++b) {
        f32x4 gs0[4], sv0[4], gs1[4], sv1[4];
#pragma unroll
        for (int j = 0; j < 4; ++j) { const int c = 8 * (F.lane + 64 * (j >> 1)) + 4 * (j & 1);
            const f32x4 g = *(const f32x4*)(g0 + c), sc = *(const f32x4*)(sc0 + (size_t)b * bs0 + c); gs0[j] = g * (sc + 1.0f); sv0[j] = *(const f32x4*)(sh0 + (size_t)b * bs0 + c);
            if (NOUT == 2) { const f32x4 gB = *(const f32x4*)(g1 + c), scB = *(const f32x4*)(sc1 + (size_t)b * bs1 + c); gs1[j] = gB * (scB + 1.0f); sv1[j] = *(const f32x4*)(sh1 + (size_t)b * bs1 + c); } }
        u32x4 rawb[2]; f32x4 rawf[4];
        auto load_row = [&](int m) {
            if constexpr (XBF) { const u32x4* xr = (const u32x4*)((const bf16*)X + (size_t)m * D) + F.lane; rawb[0] = xr[0]; rawb[1] = xr[64]; }
            else { const f32x4* xr = (const f32x4*)((const float*)X + (size_t)m * D) + 2 * F.lane; rawf[0] = __builtin_nontemporal_load(xr); rawf[1] = __builtin_nontemporal_load(xr + 1); rawf[2] = __builtin_nontemporal_load(xr + 128); rawf[3] = __builtin_nontemporal_load(xr + 129); } };
        int m = b * SEQ + gw; const int mend = (b + 1) * SEQ;
        if (m < mend) load_row(m);
        for (; m < mend; m += NGW) {
            f32x4 v[4]; float s = 0.f;
            if constexpr (XBF) {
#pragma unroll
                for (int jj = 0; jj < 2; ++jj) { const u32x4 w = rawb[jj]; v[2 * jj] = (f32x4){bflo(w.x), bfhi(w.x), bflo(w.y), bfhi(w.y)}; v[2 * jj + 1] = (f32x4){bflo(w.z), bfhi(w.z), bflo(w.w), bfhi(w.w)}; }
            } else {
#pragma unroll
                for (int j = 0; j < 4; ++j) v[j] = rawf[j]; }
            if (m + NGW < mend) load_row(m + NGW);
#pragma unroll
            for (int j = 0; j < 4; ++j) s += (v[j].x * v[j].x + v[j].y * v[j].y) + (v[j].z * v[j].z + v[j].w * v[j].w);
            const float rstd = 1.0f / sqrtf(wave_sum(s) * (1.0f / D) + RMS_EPS);
            u32x4* p0 = (u32x4*)(o0 + (size_t)m * D) + F.lane;
#pragma unroll
            for (int jj = 0; jj < 2; ++jj) { const f32x4 y0 = v[2 * jj] * rstd * gs0[2 * jj] + sv0[2 * jj], y1 = v[2 * jj + 1] * rstd * gs0[2 * jj + 1] + sv0[2 * jj + 1];
                u32x4 w; w.x = pk2(y0.x, y0.y); w.y = pk2(y0.z, y0.w); w.z = pk2(y1.x, y1.y); w.w = pk2(y1.z, y1.w); p0[64 * jj] = w; }
            if (NOUT == 2) { u32x4* p1 = (u32x4*)(o1 + (size_t)m * D) + F.lane;
#pragma unroll
                for (int jj = 0; jj < 2; ++jj) { const f32x4 y0 = v[2 * jj] * rstd * gs1[2 * jj] + sv1[2 * jj], y1 = v[2 * jj + 1] * rstd * gs1[2 * jj + 1] + sv1[2 * jj + 1];
                    u32x4 w; w.x = pk2(y0.x, y0.y); w.y = pk2(y0.z, y0.w); w.z = pk2(y1.x, y1.y); w.w = pk2(y1.z, y1.w); p1[64 * jj] = w; } }
        }
    }
}
__device__ __forceinline__ void final_norm_rows(Frame& F, const float* X, float* O, const float* g) {
    const int gw = F.bid * 8 + F.wave, NGW = F.G * 8;
    f32x4 gg[4];
#pragma unroll
    for (int j = 0; j < 4; ++j) gg[j] = *(const f32x4*)(g + 4 * (F.lane + 64 * j));
    f32x4 nx[4];
    int m = gw;
    if (m < M) { const f32x4* xr = (const f32x4*)(X + (size_t)m * D) + F.lane;
#pragma unroll
        for (int j = 0; j < 4; ++j) nx[j] = xr[64 * j]; }
    for (; m < M; m += NGW) {
        f32x4 v[4]; float s = 0.f;
#pragma unroll
        for (int j = 0; j < 4; ++j) v[j] = nx[j];
        if (m + NGW < M) { const f32x4* xr = (const f32x4*)(X + (size_t)(m + NGW) * D) + F.lane;
#pragma unroll
            for (int j = 0; j < 4; ++j) nx[j] = xr[64 * j]; }
#pragma unroll
        for (int j = 0; j < 4; ++j) s += (v[j].x * v[j].x + v[j].y * v[j].y) + (v[j].z * v[j].z + v[j].w * v[j].w);
        const float rstd = 1.0f / sqrtf(wave_sum(s) * (1.0f / D) + RMS_EPS);
        f32x4* orow = (f32x4*)(O + (size_t)m * D) + F.lane;
#pragma unroll
        for (int j = 0; j < 4; ++j) __builtin_nontemporal_store(v[j] * rstd * gg[j], orow + 64 * j);
    }
}

__device__ __forceinline__ void p_conv(Frame& F) {
    const bf16* XB = (const bf16*)(F.ws + WS_XB); bf16* XC = (bf16*)(F.ws + WS_XC);
    const float* cw = ARG_IN(F, I_CONVW); const float* cb = ARG_IN(F, I_CONVB);
    const int NT = F.G * 512;
    for (int gid = F.bid * 512 + F.tid; gid < (M / 32) * (LW / 8); gid += NT) {
        const int cg = gid % (LW / 8), chunk = gid / (LW / 8), ch = cg * 8, m0 = chunk * 32;
        float w0[8], w1[8], w2[8], w3[8], bb[8];
#pragma unroll
        for (int e = 0; e < 8; ++e) { w0[e] = cw[ch + e]; w1[e] = cw[LW + ch + e]; w2[e] = cw[2 * LW + ch + e]; w3[e] = cw[3 * LW + ch + e]; bb[e] = cb[ch + e]; }
        float x3[8], x2[8], x1[8], x0[8];
        if ((m0 % SEQ) == 0) {
#pragma unroll
            for (int e = 0; e < 8; ++e) { x3[e] = 0.f; x2[e] = 0.f; x1[e] = 0.f; }
        } else {
            unpack8(*(const u32x4*)(XB + (size_t)(m0 - 3) * LW + ch), x3); unpack8(*(const u32x4*)(XB + (size_t)(m0 - 2) * LW + ch), x2); unpack8(*(const u32x4*)(XB + (size_t)(m0 - 1) * LW + ch), x1);
        }
#pragma unroll 4
        for (int r = 0; r < 32; ++r) {
            unpack8(*(const u32x4*)(XB + (size_t)(m0 + r) * LW + ch), x0);
            float o[8];
#pragma unroll
            for (int e = 0; e < 8; ++e) { o[e] = bb[e] + w0[e] * x3[e] + w1[e] * x2[e] + w2[e] * x1[e] + w3[e] * x0[e]; x3[e] = x2[e]; x2[e] = x1[e]; x1[e] = x0[e]; }
            u32x4 w; w.x = pk2(o[0], o[1]); w.y = pk2(o[2], o[3]); w.z = pk2(o[4], o[5]); w.w = pk2(o[6], o[7]);
            *(u32x4*)(XC + (size_t)(m0 + r) * LW + ch) = w;
        }
    }
}
constexpr int SCH = 32, NCH = SEQ / SCH, CG = LW / 8;
__device__ __forceinline__ void p_scan1(Frame& F) {
    const u32x4* LA = (const u32x4*)(F.ws + WS_XB); const u32x4* BB = (const u32x4*)(F.ws + WS_BB);
    float* SA = (float*)(F.ws + WS_SA); float* SB = (float*)(F.ws + WS_SB);
    const int NT = F.G * 512;
    for (int gid = F.bid * 512 + F.tid; gid < BATCH * NCH * CG; gid += NT) {
        const int g = gid % CG, bc = gid / CG;
        const u32x4* la = LA + (size_t)bc * SCH * CG + g; const u32x4* bb = BB + (size_t)bc * SCH * CG + g;
        float h[8], sm[8];
#pragma unroll
        for (int e = 0; e < 8; ++e) { h[e] = 0.f; sm[e] = 0.f; }
#pragma unroll 1
        for (int r0 = 0; r0 < SCH; r0 += 16) {
            u32x4 lv[16], bv[16];
#pragma unroll
            for (int r = 0; r < 16; ++r) { lv[r] = la[(size_t)(r0 + r) * CG]; bv[r] = bb[(size_t)(r0 + r) * CG]; }
#pragma unroll
            for (int r = 0; r < 16; ++r) { float l[8], u[8]; unpack8(lv[r], l); unpack8(bv[r], u);
#pragma unroll
                for (int e = 0; e < 8; ++e) { h[e] = fexp2(l[e] * LOG2E) * h[e] + u[e]; sm[e] += l[e]; } }
        }
        f32x4* sa = (f32x4*)(SA + (size_t)bc * LW + 8 * g); f32x4* sb = (f32x4*)(SB + (size_t)bc * LW + 8 * g);
        sa[0] = (f32x4){fexp2(sm[0] * LOG2E), fexp2(sm[1] * LOG2E), fexp2(sm[2] * LOG2E), fexp2(sm[3] * LOG2E)};
        sa[1] = (f32x4){fexp2(sm[4] * LOG2E), fexp2(sm[5] * LOG2E), fexp2(sm[6] * LOG2E), fexp2(sm[7] * LOG2E)};
        sb[0] = (f32x4){h[0], h[1], h[2], h[3]}; sb[1] = (f32x4){h[4], h[5], h[6], h[7]};
    }
}
__device__ __forceinline__ void p_scan_carry(Frame& F) {
    const float* SA = (const float*)(F.ws + WS_SA); float* SB = (float*)(F.ws + WS_SB);
    LAS float* segA = (LAS float*)(F.lds + RING_OFF); LAS float* segB = segA + 512;
    const int seg = F.tid >> 5, cl = F.tid & 31;
    for (int it = F.bid; it < BATCH * (LW / 32); it += F.G) {
        const int b = it / (LW / 32), ch = (it % (LW / 32)) * 32 + cl;
        const size_t base = (size_t)(b * NCH + 16 * seg) * LW + ch;
        float a[16], bq[16];
#pragma unroll
        for (int j = 0; j < 16; ++j) { a[j] = SA[base + (size_t)j * LW]; bq[j] = SB[base + (size_t)j * LW]; }
        float A = 1.f, B = 0.f;
#pragma unroll
        for (int j = 0; j < 16; ++j) { B = a[j] * B + bq[j]; A *= a[j]; }
        segA[seg * 32 + cl] = A; segB[seg * 32 + cl] = B;
        __syncthreads();
        float H = 0.f;
        for (int s2 = 0; s2 < seg; ++s2) H = segA[s2 * 32 + cl] * H + segB[s2 * 32 + cl];
#pragma unroll
        for (int j = 0; j < 16; ++j) { SB[base + (size_t)j * LW] = H; H = a[j] * H + bq[j]; }
        __syncthreads();
    }
}
__device__ __forceinline__ void p_scan2(Frame& F) {
    const u32x4* LA = (const u32x4*)(F.ws + WS_XB); const u32x4* BB = (const u32x4*)(F.ws + WS_BB);
    u32x4* Y = (u32x4*)(F.ws + WS_Y); u32x4* YO = F.dry ? (u32x4*)(F.ws + WS_XC) : Y;
    const float* SB = (const float*)(F.ws + WS_SB);
    const int NT = F.G * 512;
    for (int gid = F.bid * 512 + F.tid; gid < BATCH * NCH * CG; gid += NT) {
        const int g = gid % CG, bc = gid / CG;
        const size_t base = (size_t)bc * SCH * CG + g;
        float h[8];
        { const f32x4 c0 = *(const f32x4*)(SB + (size_t)bc * LW + 8 * g), c1 = *(const f32x4*)(SB + (size_t)bc * LW + 8 * g + 4);
          h[0] = c0.x; h[1] = c0.y; h[2] = c0.z; h[3] = c0.w; h[4] = c1.x; h[5] = c1.y; h[6] = c1.z; h[7] = c1.w; }
#pragma unroll 1
        for (int r0 = 0; r0 < SCH; r0 += 8) {
            u32x4 lv[8], bv[8], yv[8];
#pragma unroll
            for (int r = 0; r < 8; ++r) { const size_t o = base + (size_t)(r0 + r) * CG; lv[r] = LA[o]; bv[r] = BB[o]; yv[r] = Y[o]; }
#pragma unroll
            for (int r = 0; r < 8; ++r) { float l[8], u[8], y[8]; unpack8(lv[r], l); unpack8(bv[r], u); unpack8(yv[r], y);
#pragma unroll
                for (int e = 0; e < 8; ++e) h[e] = fexp2(l[e] * LOG2E) * h[e] + u[e];
                u32x4 w; w.x = pk2(h[0] * y[0], h[1] * y[1]); w.y = pk2(h[2] * y[2], h[3] * y[3]); w.z = pk2(h[4] * y[4], h[5] * y[5]); w.w = pk2(h[6] * y[6], h[7] * y[7]);
                YO[base + (size_t)(r0 + r) * CG] = w; }
        }
    }
}

__device__ __forceinline__ void p_kmean(Frame& F) {
    if (F.dry && DRY_VARIANT == 5) return;
    const bf16* KB = (const bf16*)((unsigned char*)F.out + DO_KB); float* KM = (float*)(F.ws + WS_KM);
    LAS float* red = (LAS float*)(F.lds + RING_OFF);
    const int dg = F.lane & 15, rg = F.wave * 4 + (F.lane >> 4);
    for (int it = F.bid; it < BATCH * NKV * NB; it += F.G) {
        const int n = it % NB, kvh = (it / NB) % NKV, b = it / (NB * NKV);
        const u32x4* kp = (const u32x4*)(KB + (size_t)(b * SEQ + n * BLK + rg * 8) * (NKV * HD) + kvh * HD) + dg;
        float sm[8];
#pragma unroll
        for (int e = 0; e < 8; ++e) sm[e] = 0.f;
        u32x4 kv[8];
#pragma unroll
        for (int r = 0; r < 8; ++r) kv[r] = kp[(size_t)r * (NKV * HD / 8)];
#pragma unroll
        for (int r = 0; r < 8; ++r) { float x[8]; unpack8(kv[r], x);
#pragma unroll
            for (int e = 0; e < 8; ++e) sm[e] += x[e]; }
#pragma unroll
        for (int e = 0; e < 8; ++e) red[rg * 128 + 8 * dg + e] = sm[e];
        __syncthreads();
        if (F.tid < 128) { float t = 0.f;
#pragma unroll
            for (int w = 0; w < 32; ++w) t += red[w * 128 + F.tid];
            KM[(size_t)it * HD + F.tid] = t * (1.0f / BLK); }
        __syncthreads();
    }
}
#define MFMA32(a, b, c) __builtin_amdgcn_mfma_f32_32x32x16_bf16((a), (b), (c), 0, 0, 0)
__device__ __forceinline__ void top3_insert(float g, int n, float& v0, float& v1, float& v2, int& i0, int& i1, int& i2) {
    const bool c0 = g > v0, c1 = g > v1, c2 = g > v2;
    const float nv2 = c1 ? v1 : (c2 ? g : v2); const int ni2 = c1 ? i1 : (c2 ? n : i2);
    const float nv1 = c0 ? v0 : (c1 ? g : v1); const int ni1 = c0 ? i0 : (c1 ? n : i1);
    v0 = c0 ? g : v0; i0 = c0 ? n : i0; v1 = nv1; i1 = ni1; v2 = nv2; i2 = ni2;
}
__device__ __forceinline__ void gate_group(const bf16* QB, const bf16x8 (&kh)[8], const bf16x8 (&kl)[8], LAS int* cntl, int b, int tg, int h, int kvh, int li, int hi, int own,
                                           int& s0, int& s1, int& s2, int& p0, int& p1, int& p2) {
    const int t = tg + li;
    const bf16* qp = QB + (size_t)(b * SEQ + t) * D + h * HD + 8 * hi;
    f32x16 acc;
#pragma unroll
    for (int r = 0; r < 16; ++r) acc[r] = 0.f;
#pragma unroll
    for (int ks = 0; ks < 8; ++ks) { const bf16x8 qf = *(const bf16x8*)(qp + 16 * ks); acc = MFMA32(kh[ks], qf, acc); acc = MFMA32(kl[ks], qf, acc); }
    int i0 = -1, i1 = -1, i2 = -1; float v0 = -3.0e38f, v1 = -3.0e38f, v2 = -3.0e38f;
#pragma unroll
    for (int r = 0; r < 16; ++r) { const int n = (r & 3) + 8 * (r >> 2) + 4 * hi; top3_insert(n < own ? acc[r] : -3.0e38f, n, v0, v1, v2, i0, i1, i2); }
    const float w0 = __shfl_xor(v0, 32), w1 = __shfl_xor(v1, 32), w2 = __shfl_xor(v2, 32);
    const int j0 = __shfl_xor(i0, 32), j1 = __shfl_xor(i1, 32), j2 = __shfl_xor(i2, 32);
    top3_insert(j0 >= 0 ? w0 : -3.0e38f, j0, v0, v1, v2, i0, i1, i2);
    top3_insert(j1 >= 0 ? w1 : -3.0e38f, j1, v0, v1, v2, i0, i1, i2);
    top3_insert(j2 >= 0 ? w2 : -3.0e38f, j2, v0, v1, v2, i0, i1, i2);
    s0 = i0; s1 = i1; s2 = i2; p0 = 0; p1 = 0; p2 = 0;
    if (hi == 0) {
        if (i0 >= 0) p0 = __hip_atomic_fetch_add(&cntl[kvh * NB + i0], 1, __ATOMIC_RELAXED, __HIP_MEMORY_SCOPE_WORKGROUP);
        if (i1 >= 0) p1 = __hip_atomic_fetch_add(&cntl[kvh * NB + i1], 1, __ATOMIC_RELAXED, __HIP_MEMORY_SCOPE_WORKGROUP);
        if (i2 >= 0) p2 = __hip_atomic_fetch_add(&cntl[kvh * NB + i2], 1, __ATOMIC_RELAXED, __HIP_MEMORY_SCOPE_WORKGROUP);
    }
}
__device__ __forceinline__ void p_gate(Frame& F) {
    const bf16* QB = (const bf16*)((unsigned char*)F.out + DO_QB); const float* KM = (const float*)(F.ws + WS_KM);
    unsigned* LIST = (unsigned*)(F.ws + (F.dry ? WS_OP : WS_LIST)); unsigned* gcnt = (unsigned*)(F.ws + WS_CTL) + CW_LCNT + (F.dry ? 256 : 0);
    LAS int* cntl = (LAS int*)(F.lds + RING_OFF);
    const int h = F.wave, kvh = h >> 1, li = F.lane & 31, hi = F.lane >> 5;
    for (int tile = F.bid; tile < M / 64; tile += F.G) {
        const int b = tile / (SEQ / 64), t0 = (tile % (SEQ / 64)) * 64, own = t0 / BLK;
        if (F.tid < 256) cntl[F.tid] = 0;
        __syncthreads();
        bf16x8 kh[8], kl[8];
        { const float* kmp = KM + ((size_t)((b * NKV + kvh) * NB + li)) * HD + 8 * hi;
#pragma unroll
          for (int ks = 0; ks < 8; ++ks) { const f32x4 a = *(const f32x4*)(kmp + 16 * ks), c = *(const f32x4*)(kmp + 16 * ks + 4);
              u32x4 wh; wh.x = pk2(a.x, a.y); wh.y = pk2(a.z, a.w); wh.z = pk2(c.x, c.y); wh.w = pk2(c.z, c.w);
              u32x4 wl; wl.x = pk2(a.x - bflo(wh.x), a.y - bfhi(wh.x)); wl.y = pk2(a.z - bflo(wh.y), a.w - bfhi(wh.y)); wl.z = pk2(c.x - bflo(wh.z), c.y - bfhi(wh.z)); wl.w = pk2(c.z - bflo(wh.w), c.w - bfhi(wh.w));
              kh[ks] = __builtin_bit_cast(bf16x8, wh); kl[ks] = __builtin_bit_cast(bf16x8, wl); } }
        int sa0, sa1, sa2, pa0, pa1, pa2, sb0, sb1, sb2, pb0, pb1, pb2;
        gate_group(QB, kh, kl, cntl, b, t0, h, kvh, li, hi, own, sa0, sa1, sa2, pa0, pa1, pa2);
        gate_group(QB, kh, kl, cntl, b, t0 + 32, h, kvh, li, hi, own, sb0, sb1, sb2, pb0, pb1, pb2);
        __syncthreads();
        if (F.tid < 128) { const int c = cntl[F.tid]; int base = 0; if (c > 0) base = (int)atomicAdd(&gcnt[b * 128 + F.tid], (unsigned)c); cntl[128 + F.tid] = base; }
        __syncthreads();
        if (hi == 0) {
            const size_t lb = (size_t)(b * 128 + kvh * NB); const int cb = 128 + kvh * NB;
            const unsigned ea = ((unsigned)(t0 + li) << 3) | ((unsigned)(h & 1) << 2), eb = ((unsigned)(t0 + 32 + li) << 3) | ((unsigned)(h & 1) << 2);
            if (sa0 >= 0) LIST[(lb + sa0) * LIST_CAP + cntl[cb + sa0] + pa0] = ea | 0u;
            if (sa1 >= 0) LIST[(lb + sa1) * LIST_CAP + cntl[cb + sa1] + pa1] = ea | 1u;
            if (sa2 >= 0) LIST[(lb + sa2) * LIST_CAP + cntl[cb + sa2] + pa2] = ea | 2u;
            if (sb0 >= 0) LIST[(lb + sb0) * LIST_CAP + cntl[cb + sb0] + pb0] = eb | 0u;
            if (sb1 >= 0) LIST[(lb + sb1) * LIST_CAP + cntl[cb + sb1] + pb1] = eb | 1u;
            if (sb2 >= 0) LIST[(lb + sb2) * LIST_CAP + cntl[cb + sb2] + pb2] = eb | 2u;
        }
        __syncthreads();
    }
}

constexpr int HBUF = 65536;
__device__ __forceinline__ void build_bias_table(Frame& F) {
    LAS float* BT = (LAS float*)(F.lds + BT_OFF);
    for (int i = F.tid; i < NH * 128; i += 512) { const int h = i >> 7, d = i & 127; int bk;
        if (d < 16) bk = d; else { bk = 16 + (int)(logf((float)d / 16.0f) / 2.0794415416798357f * 16.0f); bk = bk < 31 ? bk : 31; }
        BT[i] = ARG_IN(F, I_RELB)[h * 32 + bk] * LOG2E; }
}
__device__ __forceinline__ void glds_half(Frame& F, int b, int kvh, int n, int half, int buf) {
    int ln = F.lane; asm volatile("" : "+v"(ln));
    const int wv = F.wave;
    const char* kb = (const char*)((const bf16*)((unsigned char*)F.out + DO_KB) + (size_t)(b * SEQ + n * BLK + half * 128 + 16 * wv) * (NKV * HD) + kvh * HD);
    const char* vb = (const char*)((const bf16*)((unsigned char*)F.out + DO_VT) + (size_t)(kvh * HD + 16 * wv) * M + b * SEQ + n * BLK + half * 128);
    const int r4 = ln >> 4, slot = ln & 15;
#pragma unroll
    for (int i = 0; i < 4; ++i) { const int rr = 4 * i + r4; const unsigned ko = (unsigned)(rr * (NKV * HD) * 2 + ((slot ^ rr) << 4));
        __builtin_amdgcn_global_load_lds((const unsigned*)(kb + ko), (LAS unsigned*)(F.lds + RING_OFF + buf * HBUF + (wv * 4 + i) * 1024), 16, 0, 0); }
#pragma unroll
    for (int i = 0; i < 4; ++i) { const int rr = 4 * i + r4; const unsigned vo = (unsigned)rr * (unsigned)(M * 2) + (unsigned)((slot ^ rr) << 4);
        __builtin_amdgcn_global_load_lds((const unsigned*)(vb + vo), (LAS unsigned*)(F.lds + RING_OFF + buf * HBUF + 32768 + (wv * 4 + i) * 1024), 16, 0, 0); }
}
#define ATT_WAIT_BAR() do { asm volatile("s_waitcnt vmcnt(0) lgkmcnt(0)" ::: "memory"); __builtin_amdgcn_s_barrier(); asm volatile("" ::: "memory"); } while (0)
struct AttState { f32x16 o[4]; float m, l; };
template <int MODE>
__device__ __forceinline__ void attn_tile(Frame& F, AttState& st, const bf16x8 (&qf)[8], const int kbase, const int vbase, int kt, int qpos, int hbase, float cb) {
    const int hi = F.lane >> 5;
    const LAS float* BT = (const LAS float*)(F.lds + BT_OFF) + hbase;
    const LAS unsigned char* hb = F.lds + RING_OFF + (kt >> 1) * HBUF;
    const int kl = kt & 1;
    f32x16 s[2];
#pragma unroll
    for (int sub = 0; sub < 2; ++sub) {
        f32x16 a;
#pragma unroll
        for (int r = 0; r < 16; ++r) a[r] = 0.f;
#pragma unroll
        for (int ks = 0; ks < 8; ++ks) { const bf16x8 kf = *(const LAS bf16x8*)(hb + (kbase ^ (ks << 5)) + (64 * kl + 32 * sub) * 256); a = MFMA32(kf, qf[ks], a); }
        s[sub] = a;
    }
    float mx = -1.0e30f;
#pragma unroll
    for (int sub = 0; sub < 2; ++sub)
#pragma unroll
        for (int r = 0; r < 16; ++r) { const int key = 64 * kt + 32 * sub + (r & 7) + 8 * hi + 16 * (r >> 3);
            float v = s[sub][r];
            if (MODE == 0) v += cb;
            else { const int dist = qpos - key; const int idx = dist < 0 ? 0 : (dist > 127 ? 127 : dist); v += BT[idx]; if (MODE == 2 && dist < 0) v = -1.0e30f; }
            s[sub][r] = v; mx = fmaxf(mx, v); }
    mx = fmaxf(mx, __shfl_xor(mx, 32));
    if (__any(mx > st.m)) {
        const float mnew = fmaxf(st.m, mx), alpha = fexp2(st.m - mnew);
        st.m = mnew; st.l *= alpha;
#pragma unroll
        for (int db = 0; db < 4; ++db) st.o[db] = st.o[db] * alpha;
    }
    const float mcur = st.m;
    float ls = 0.f;
#pragma unroll
    for (int sub = 0; sub < 2; ++sub) {
        bf16x8 pf[2];
#pragma unroll
        for (int sh = 0; sh < 2; ++sh) { float p[8];
#pragma unroll
            for (int j = 0; j < 8; ++j) { p[j] = fexp2(s[sub][8 * sh + j] - mcur); ls += p[j]; }
            u32x4 w; w.x = pk2(p[0], p[1]); w.y = pk2(p[2], p[3]); w.z = pk2(p[4], p[5]); w.w = pk2(p[6], p[7]);
            pf[sh] = __builtin_bit_cast(bf16x8, w); }
#pragma unroll
        for (int db = 0; db < 4; ++db)
#pragma unroll
            for (int sh = 0; sh < 2; ++sh) { const bf16x8 vf = *(const LAS bf16x8*)(hb + 32768 + (vbase ^ ((kl * 4 + sub * 2 + sh) << 5)) + db * 32 * 256);
                st.o[db] = MFMA32(vf, pf[sh], st.o[db]); }
    }
    st.l += ls;
}
__device__ __forceinline__ void attn_lane_offsets(int lane, int& kbase, int& vbase) {
    const int i = lane & 31, hi = lane >> 5;
    const int pi = (i & ~12) | ((i & 8) >> 1) | ((i & 4) << 1);
    kbase = pi * 256 + (((hi ^ pi) & 15) << 4);
    vbase = i * 256 + (((hi ^ i) & 15) << 4);
}
__device__ __forceinline__ void attn_init(AttState& st) {
#pragma unroll
    for (int db = 0; db < 4; ++db)
#pragma unroll
        for (int r = 0; r < 16; ++r) st.o[db][r] = 0.f;
    st.m = -1.0e30f; st.l = 0.f;
}
__device__ __forceinline__ void store_row16(const f32x16 (&o)[4], float scale, bf16* rowp, int hi) {
#pragma unroll
    for (int db = 0; db < 4; ++db)
#pragma unroll
        for (int g = 0; g < 4; g += 2) {
            unsigned a0 = pk2(o[db][4 * g] * scale, o[db][4 * g + 1] * scale), a1 = pk2(o[db][4 * g + 2] * scale, o[db][4 * g + 3] * scale);
            unsigned b0 = pk2(o[db][4 * g + 4] * scale, o[db][4 * g + 5] * scale), b1 = pk2(o[db][4 * g + 6] * scale, o[db][4 * g + 7] * scale);
            const auto r0 = __builtin_amdgcn_permlane32_swap(a0, b0, false, false); const auto r1 = __builtin_amdgcn_permlane32_swap(a1, b1, false, false);
            u32x4 w; w.x = r0[0]; w.y = r1[0]; w.z = r0[1]; w.w = r1[1];
            *(u32x4*)(rowp + 32 * db + 8 * (g + hi)) = w; }
}
__device__ __forceinline__ void addrow16(f32x16 (&o)[4], float cs, const bf16* rowp, int hi) {
#pragma unroll
    for (int db = 0; db < 4; ++db)
#pragma unroll
        for (int g = 0; g < 4; g += 2) {
            const u32x4 w = *(const u32x4*)(rowp + 32 * db + 8 * (g + hi));
            const auto r0 = __builtin_amdgcn_permlane32_swap(w.x, w.z, false, false); const auto r1 = __builtin_amdgcn_permlane32_swap(w.y, w.w, false, false);
            o[db][4 * g] += cs * bflo(r0[0]); o[db][4 * g + 1] += cs * bfhi(r0[0]); o[db][4 * g + 2] += cs * bflo(r1[0]); o[db][4 * g + 3] += cs * bfhi(r1[0]);
            o[db][4 * g + 4] += cs * bflo(r0[1]); o[db][4 * g + 5] += cs * bfhi(r0[1]); o[db][4 * g + 6] += cs * bflo(r1[1]); o[db][4 * g + 7] += cs * bfhi(r1[1]); }
}
__device__ __forceinline__ unsigned pk4_fp8(float a, float b, float c, float d) { unsigned w = 0; w = __builtin_amdgcn_cvt_pk_fp8_f32(a, b, w, false); w = __builtin_amdgcn_cvt_pk_fp8_f32(c, d, w, true); return w; }
__device__ __forceinline__ void store_row_fp8(const f32x16 (&o)[4], float scale, unsigned char* rowp, int hi) {
#pragma unroll
    for (int db = 0; db < 4; ++db) {
        unsigned W[4];
#pragma unroll
        for (int g = 0; g < 4; ++g) W[g] = pk4_fp8(o[db][4 * g] * scale, o[db][4 * g + 1] * scale, o[db][4 * g + 2] * scale, o[db][4 * g + 3] * scale);
        const auto r0 = __builtin_amdgcn_permlane32_swap(W[0], W[2], false, false);
        const auto r1 = __builtin_amdgcn_permlane32_swap(W[1], W[3], false, false);
        u32x4 w; w.x = r0[0]; w.y = r0[1]; w.z = r1[0]; w.w = r1[1];
        *(u32x4*)(rowp + 32 * db + 16 * hi) = w; }
}
__device__ __forceinline__ void addrow_fp8(f32x16 (&o)[4], float cs, const unsigned char* rowp, int hi) {
#pragma unroll
    for (int db = 0; db < 4; ++db) {
        const u32x4 x = *(const u32x4*)(rowp + 32 * db + 16 * hi);
        const auto r0 = __builtin_amdgcn_permlane32_swap(x.x, x.y, false, false);
        const auto r1 = __builtin_amdgcn_permlane32_swap(x.z, x.w, false, false);
        const unsigned G[4] = {r0[0], r1[0], r0[1], r1[1]};
#pragma unroll
        for (int g = 0; g < 4; ++g) { o[db][4 * g] += cs * __builtin_amdgcn_cvt_f32_fp8(G[g], 0); o[db][4 * g + 1] += cs * __builtin_amdgcn_cvt_f32_fp8(G[g], 1);
            o[db][4 * g + 2] += cs * __builtin_amdgcn_cvt_f32_fp8(G[g], 2); o[db][4 * g + 3] += cs * __builtin_amdgcn_cvt_f32_fp8(G[g], 3); } }
}
__device__ __forceinline__ int find_list(const LAS int* pre, int item) {
    int lo = 0, hi = 256;
#pragma unroll
    for (int it = 0; it < 8; ++it) { const int mid = (lo + hi) >> 1; if (pre[mid] <= item) lo = mid; else hi = mid; }
    return __builtin_amdgcn_readfirstlane(lo);
}

__device__ __forceinline__ void p_attn_sparse(Frame& F) {
    const bf16* QB = (const bf16*)((unsigned char*)F.out + DO_QB); const unsigned* LIST = (const unsigned*)(F.ws + WS_LIST);
    unsigned* gcnt = (unsigned*)(F.ws + WS_CTL) + CW_LCNT;
    bf16* OP = (bf16*)(F.ws + WS_OP); f32x2* ML = (f32x2*)(F.ws + WS_ML);
    LAS int* pre = (LAS int*)(F.lds + PRE_OFF);
    LAS int* cnts = pre + 264;
    build_bias_table(F);
    if (F.tid < 256) { const int c = (int)__hip_atomic_load(gcnt + F.tid, RLX_AGENT); cnts[F.tid] = c; pre[F.tid + 1] = (c + 255) >> 8; }
    __syncthreads();
    if (F.tid == 0) { int s = 0; pre[0] = 0; for (int i = 1; i <= 256; ++i) { s += pre[i]; pre[i] = s; } }
    __syncthreads();
    const int total = (F.dry && DRY_VARIANT == 3) ? 0 : pre[256];
    int kbase, vbase; attn_lane_offsets(F.lane, kbase, vbase);
    const int hi = F.lane >> 5;
    int item = F.bid;
    int l = 0;
    unsigned ent = 0; bf16x8 qf[8]; bool valid = false;
#define SPARSE_FETCH_ENT(l_, item_) do { const int chunk_ = (item_) - pre[l_]; const int cnt_ = cnts[l_]; const int ri_ = chunk_ * 256 + F.wave * 32 + (F.lane & 31); \
        ent = LIST[(size_t)(l_) * LIST_CAP + (ri_ < cnt_ ? ri_ : cnt_ - 1)]; } while (0)
#define SPARSE_FETCH_Q(l_) do { const int t_ = (int)(ent >> 3), h_ = 2 * (((l_) >> 5) & 3) + (int)((ent >> 2) & 1u); const unsigned mrow_ = (unsigned)(((l_) >> 7) * SEQ + t_); \
        _Pragma("unroll") for (int ks = 0; ks < 8; ++ks) qf[ks] = *(const bf16x8*)(QB + (mrow_ * D + h_ * HD + 16 * ks + 8 * hi)); } while (0)
    if (item < total) { l = find_list(pre, item); glds_half(F, l >> 7, (l >> 5) & 3, l & 31, 0, 0); SPARSE_FETCH_ENT(l, item); SPARSE_FETCH_Q(l); ATT_WAIT_BAR(); }
    while (item < total) {
        const int b = l >> 7, kvh = (l >> 5) & 3, n = l & 31;
        const int t = (int)(ent >> 3), h = 2 * kvh + (int)((ent >> 2) & 1u), slot = (int)(ent & 3u);
        const unsigned mrow = (unsigned)(b * SEQ + t);
        glds_half(F, b, kvh, n, 1, 1);
        AttState st; attn_init(st);
        const int qpos = t - n * BLK;
        const LAS float* BT = (const LAS float*)(F.lds + BT_OFF);
        const float cb = BT[h * 128 + 127];
        const bool far = __all(qpos - 255 >= 127);
        if (far) {
#pragma unroll 1
            for (int kt = 0; kt < 2; ++kt) attn_tile<0>(F, st, qf, kbase, vbase, kt, qpos, h * 128, cb);
        } else {
#pragma unroll 1
            for (int kt = 0; kt < 2; ++kt) attn_tile<1>(F, st, qf, kbase, vbase, kt, qpos, h * 128, cb);
        }
        ATT_WAIT_BAR();
        const int item2 = item + F.G; int l2 = 0; const bool more = item2 < total;
        if (more) { l2 = find_list(pre, item2); glds_half(F, l2 >> 7, (l2 >> 5) & 3, l2 & 31, 0, 0); SPARSE_FETCH_ENT(l2, item2); }
        if (far) {
#pragma unroll 1
            for (int kt = 2; kt < 4; ++kt) attn_tile<0>(F, st, qf, kbase, vbase, kt, qpos, h * 128, cb);
        } else {
#pragma unroll 1
            for (int kt = 2; kt < 4; ++kt) attn_tile<1>(F, st, qf, kbase, vbase, kt, qpos, h * 128, cb);
        }
        if (more) { SPARSE_FETCH_Q(l2); }
        asm volatile("s_waitcnt vmcnt(8)" ::: "memory");
        __builtin_amdgcn_s_barrier(); asm volatile("" ::: "memory");
        const float lt = st.l + __shfl_xor(st.l, 32); const float inv = 1.0f / lt;
        {
            const unsigned prow = (mrow * NH + h) * 3 + slot;
            store_row_fp8(st.o, inv, (unsigned char*)OP + (size_t)prow * HD, hi);
            if (hi == 0) ML[prow] = (f32x2){st.m, lt};
        }
        item = item2; l = l2;
    }
#undef SPARSE_FETCH_ENT
#undef SPARSE_FETCH_Q
    ATT_WAIT_BAR();
}
__device__ __forceinline__ void p_attn_own(Frame& F) {
    const bf16* QB = (const bf16*)((unsigned char*)F.out + DO_QB); bf16* OB = (bf16*)((unsigned char*)F.out + DO_QB);
    const bf16* OP = (const bf16*)(F.ws + WS_OP); const f32x2* ML = (const f32x2*)(F.ws + WS_ML);
    build_bias_table(F);
    int kbase, vbase; attn_lane_offsets(F.lane, kbase, vbase);
    const int hi = F.lane >> 5;
    for (int item = F.bid; item < BATCH * NKV * NB; item += F.G) {
        const int kvh = item % NKV, j = (item / NKV) % NB, b = item / (NKV * NB);
        glds_half(F, b, kvh, j, 0, 0); glds_half(F, b, kvh, j, 1, 1);
        ATT_WAIT_BAR();
#pragma unroll 1
        for (int task = 0; task < 2; ++task) {
            const int h = 2 * kvh + task, qg = task ? 7 - F.wave : F.wave;
            const int qpos = qg * 32 + (F.lane & 31), t = j * BLK + qpos;
            const unsigned mrow = (unsigned)(b * SEQ + t);
            bf16x8 qf[8];
#pragma unroll
            for (int ks = 0; ks < 8; ++ks) qf[ks] = *(const bf16x8*)(QB + (mrow * D + h * HD + 16 * ks + 8 * hi));
            AttState st; attn_init(st);
            const int ntile = (qg >> 1) + 1;
#pragma unroll 1
            for (int kt = 0; kt < ntile; ++kt) attn_tile<2>(F, st, qf, kbase, vbase, kt, qpos, h * 128, 0.f);
            const float lo = st.l + __shfl_xor(st.l, 32);
            const int nvalid = j < 3 ? j : 3;
            const unsigned prow = (mrow * NH + h) * 3;
            f32x2 ml[3]; float mxx = st.m;
#pragma unroll
            for (int s = 0; s < 3; ++s) { ml[s] = (f32x2){-1.0e30f, 0.f}; if (s < nvalid) { ml[s] = ML[prow + s]; mxx = fmaxf(mxx, ml[s].x); } }
            const float co = fexp2(st.m - mxx); float den = co * lo;
#pragma unroll
            for (int db = 0; db < 4; ++db) st.o[db] = st.o[db] * co;
#pragma unroll
            for (int s = 0; s < 3; ++s) if (s < nvalid) { const float cs = ml[s].y * fexp2(ml[s].x - mxx); den += cs;
                addrow_fp8(st.o, cs, (const unsigned char*)OP + (size_t)(prow + s) * HD, hi); }
            const float inv = 1.0f / den;
            bf16* ob = F.dry ? (bf16*)(F.ws + WS_LIST) + ((mrow & 8191u) * D + h * HD) : OB + (mrow * D + h * HD);
            store_row16(st.o, inv, ob, hi);
        }
        ATT_WAIT_BAR();
    }
}

__global__ void __launch_bounds__(512, 2) yoco_fwd(Args args) {
    extern __shared__ __attribute__((aligned(16))) unsigned char lds_raw[];
    Frame F;
    F.lds = (LAS unsigned char*)lds_raw;
    F.tid = threadIdx.x; F.lane = F.tid & 63; F.wave = __builtin_amdgcn_readfirstlane(F.tid >> 6); F.G = gridDim.x;
    F.out = args.out; F.ws = args.ws; F.kp = (const CAS unsigned char*)__builtin_amdgcn_kernarg_segment_ptr();
    unsigned char* ws = args.ws;
    for (int u = F.tid; u < (LDS_BYTES - LDSCTL_OFF) / 4; u += 512) ((LAS unsigned*)(F.lds + LDSCTL_OFF))[u] = 0u;
    __syncthreads();
    volatile LAS unsigned* MISC = (volatile LAS unsigned*)(F.lds + MISC_OFF);
    XcdBarrier bar; bar.bar = (unsigned*)(ws + WS_CTL) + CW_BAR; bar.x = 0; bar.st = nullptr;
    const int lo = args.ph_lo, hi = args.ph_hi;
    if (hi - lo > 1) bar = xcd_barrier_post((unsigned*)(ws + WS_CTL) + CW_BAR, MISC + 8);
#ifndef PHASE_MASK
#define PHASE_MASK 0xffffffffu
#endif
#define EN(k) (((PHASE_MASK) >> (k)) & 1u)
    for (int pid = lo; pid < hi; ++pid) {
      const int nrep = 1 + (int)((REPEAT_SET >> pid) & 1u);
      for (int rep = 0; rep < nrep; ++rep) {
        fresh_ids(F); ws = F.ws; F.dry = rep;
        const int cid = F.bid;
        float* MOD0 = (float*)(ws + WS_MOD0); float* MOD1 = (float*)(ws + WS_MOD1); float* KVMOD = (float*)(ws + WS_KVMOD);
        switch (pid) {
        case 0: if (EN(0)) { p_modgemv(F); } break;
        case 1: if (EN(1)) { p_weights(F, 0, F.bid * 8 + F.wave, F.G * 8); norm_mod_rows<1, false>(F, ARG_IN(F, I_X), ARG_IN(F, I_NMIX), MOD0, MOD0 + D, 6 * D, (bf16*)(ws + WS_H_L0), nullptr, nullptr, nullptr, 0, nullptr); } break;
        case 2: if (EN(2)) { pg8::Gemm g{(const bf16*)(ws + WS_H_L0), (const bf16*)(ws + WS_WIN), M, 2 * LW, D, D}; pg8::StaticOrder S; S.init(M, 2 * LW, F.G, cid);
                pg8::EpiInProj E{(bf16*)(ws + WS_Y), (bf16*)(ws + WS_XB)};
                pg8::gemm_phase<pg8::EpiInProj, pg8::StaticOrder, true>(F.lds + RING_OFF, g, S, E); p_weights_bubble(F, 1); } break;
        case 3: if (EN(3)) p_conv(F); break;
        case 4: if (EN(4)) { pg8::Gemm g{(const bf16*)(ws + WS_XC), (const bf16*)(ws + WS_WG), M, 2 * LW, LB, LW}; pg8::GatesOrder S{F.G, cid};
                pg8::EpiGates E{(const bf16*)(ws + WS_XC), (bf16*)(ws + WS_XB), (bf16*)(ws + WS_BB), ARG_IN(F, I_BGATES), ARG_IN(F, I_BGATES) + LW, (const float*)(ws + WS_C8)};
                pg8::gemm_phase<pg8::EpiGates, pg8::GatesOrder, true>(F.lds + RING_OFF, g, S, E); p_weights_bubble(F, 2); } break;
        case 5: if (EN(5)) p_scan1(F); break;
        case 6: if (EN(6)) p_scan_carry(F); break;
        case 7: if (EN(6)) p_scan2(F); break;
        case 8: case 18: if (EN(7)) { const int layer = pid == 18; float* MOD = layer ? MOD1 : MOD0;
                pg8::Gemm g; pg8::EpiResid E; pg8::StaticOrder S; S.init(M, D, F.G, cid);
                if (layer == 0) { g = pg8::Gemm{(const bf16*)(ws + WS_Y), (const bf16*)(ws + WS_WOUT), M, D, LW, LW}; E = pg8::EpiResid{ARG_IN(F, I_X), ws + WS_XS, MOD + 2 * D, 6 * D, 0, 1}; }
                else { g = pg8::Gemm{(const bf16*)((unsigned char*)F.out + DO_QB), (const bf16*)(ws + WS_WO), M, D, D, D}; E = pg8::EpiResid{ws + WS_XS, ws + WS_XS, MOD + 2 * D, 6 * D, 1, 1}; }
                pg8::gemm_phase<pg8::EpiResid, pg8::StaticOrder, true>(F.lds + RING_OFF, g, S, E); } break;
        case 9: case 19: if (EN(8)) { const int layer = pid == 19; float* MOD = layer ? MOD1 : MOD0;
                norm_mod_rows<1, true>(F, ws + WS_XS, ARG_IN(F, I_NFFN) + layer * D, MOD + 3 * D, MOD + 4 * D, 6 * D, (bf16*)(ws + (layer ? WS_H_F1 : WS_H_F0)), nullptr, nullptr, nullptr, 0, nullptr); } break;
        case 10: case 20: if (EN(9)) { const int layer = pid == 20;
                pg8::Gemm g{(const bf16*)(ws + (layer ? WS_H_F1 : WS_H_F0)), (const bf16*)(ws + (layer ? WS_WGU1 : WS_WGU0)), M, 2 * FF, D, D}; pg8::StaticOrder S; S.init(M, 2 * FF, F.G, cid);
                pg8::EpiSwiGLU E{(bf16*)(ws + (layer ? WS_HF1 : WS_HF0))};
                pg8::gemm_phase<pg8::EpiSwiGLU, pg8::StaticOrder, true>(F.lds + RING_OFF, g, S, E); } break;
        case 11: case 21: if (EN(10)) { const int layer = pid == 21; float* MOD = layer ? MOD1 : MOD0;
                pg8::Gemm g{(const bf16*)(ws + (layer ? WS_HF1 : WS_HF0)), (const bf16*)(ws + (layer ? WS_WD1 : WS_WD0)), M, D, FF, FF}; pg8::StaticOrder S; S.init(M, D, F.G, cid);
                pg8::EpiResid E{ws + WS_XS, layer ? (void*)F.out : (void*)(ws + WS_XS), MOD + 5 * D, 6 * D, 1, layer ? 0 : 1};
                pg8::gemm_phase<pg8::EpiResid, pg8::StaticOrder, true>(F.lds + RING_OFF, g, S, E); } break;
        case 12: if (EN(11)) norm_mod_rows<2, true>(F, ws + WS_XS, ARG_IN(F, I_KVNORM), KVMOD, KVMOD + D, 2 * D, (bf16*)(ws + WS_HKV), ARG_IN(F, I_NMIX) + D, MOD1, MOD1 + D, 6 * D, (bf16*)(ws + WS_H_L1)); break;
        case 13: if (EN(12)) {
                for (int g3 = 0; g3 < 3; ++g3) {
                    pg8::Gemm g; pg8::EpiPlain E; pg8::StaticOrder S;
                    if (g3 == 0) { g = pg8::Gemm{(const bf16*)(ws + WS_HKV), (const bf16*)(ws + WS_WKV), M, NKV * HD, D, D}; E = pg8::EpiPlain{(bf16*)((unsigned char*)F.out + DO_KB), NKV * HD, 1.0f}; S.init(M, NKV * HD, F.G, cid); }
                    else if (g3 == 1) { g = pg8::Gemm{(const bf16*)(ws + WS_WKV) + (size_t)(NKV * HD) * D, (const bf16*)(ws + WS_HKV), NKV * HD, M, D, D}; E = pg8::EpiPlain{(bf16*)((unsigned char*)F.out + DO_VT), M, 1.0f};
                        S.init(NKV * HD, M, F.G, F.G >= 256 ? (cid + 128) % F.G : cid); }
                    else { g = pg8::Gemm{(const bf16*)(ws + WS_H_L1), (const bf16*)(ws + WS_WQ), M, D, D, D}; E = pg8::EpiPlain{(bf16*)((unsigned char*)F.out + DO_QB), D, 0.08838834764831845f * LOG2E}; S.init(M, D, F.G, cid); }
                    pg8::gemm_phase<pg8::EpiPlain, pg8::StaticOrder, true>(F.lds + RING_OFF, g, S, E);
                } } break;
        case 14: if (EN(13)) p_kmean(F); break;
        case 15: if (EN(14)) p_gate(F); break;
        case 16: if (EN(15)) p_attn_sparse(F); break;
        case 17: if (EN(16)) p_attn_own(F); break;
        default: if (EN(22)) final_norm_rows(F, F.out, F.dry ? (float*)(ws + ACT) : F.out, ARG_IN(F, I_FNORM)); break;
        }
        if (pid + 1 < hi || rep + 1 < nrep) { bar.bar = (unsigned*)(ws + WS_CTL) + CW_BAR; xcd_barrier(bar); }
      }
    }
}
constexpr int N_PHASES = 23;

extern "C" void kernel_launch(void* const* d_in, const int* in_sizes, int n_in, void* d_out, int out_size, void* d_ws, size_t ws_size, hipStream_t stream) {
    static int grid = 0;
    if (grid == 0) {
        if (n_in != 24 || out_size != M * D || ws_size < WS_END) { fprintf(stderr, "kernel_launch: unexpected shapes (n_in %d out %d ws %zu)\n", n_in, out_size, ws_size); grid = -1; return; }
        int dev = 0, cus = 0;
        if (hipGetDevice(&dev) != hipSuccess || hipDeviceGetAttribute(&cus, hipDeviceAttributeMultiprocessorCount, dev) != hipSuccess) { grid = -1; return; }
        if (hipFuncSetAttribute((const void*)yoco_fwd, hipFuncAttributeMaxDynamicSharedMemorySize, LDS_BYTES) != hipSuccess) { fprintf(stderr, "kernel_launch: hipFuncSetAttribute failed\n"); grid = -1; return; }
        (void)hipGetLastError();
        grid = cus;
    }
    if (grid < 0) return;
    if (hipMemsetAsync((char*)d_ws + WS_CTL, 0, CTL_ZERO_BYTES, stream) != hipSuccess) return;
    Args a{};
    for (int i = 0; i < 24; ++i) a.in[i] = (const float*)d_in[i];
    a.out = (float*)d_out; a.ws = (unsigned char*)d_ws;
#if MK_N_LAUNCHES == 1
    a.ph_lo = 0; a.ph_hi = N_PHASES;
    hipLaunchKernelGGL(yoco_fwd, dim3(grid), dim3(512), LDS_BYTES, stream, a);
#else
    for (int p = 0; p < N_PHASES; ++p) { a.ph_lo = p; a.ph_hi = p + 1; hipLaunchKernelGGL(yoco_fwd, dim3(grid), dim3(512), LDS_BYTES, stream, a); }
#endif
}
```

```cpp
#include <hip/hip_runtime.h>
#include <cstdio>
#include <cstdint>
#include <cstddef>

#ifndef MK_N_LAUNCHES
#define MK_N_LAUNCHES 1
#endif

#define DRY_VARIANT 2
#define REPEAT_SET 0x0u
#define GAS __attribute__((address_space(1)))
#define LAS __attribute__((address_space(3)))
typedef unsigned short bf16;
typedef short bf16x8 __attribute__((ext_vector_type(8)));
typedef float f32x2 __attribute__((ext_vector_type(2)));
typedef float f32x4 __attribute__((ext_vector_type(4)));
typedef float f32x16 __attribute__((ext_vector_type(16)));
typedef unsigned u32x2 __attribute__((ext_vector_type(2)));
typedef unsigned u32x4 __attribute__((ext_vector_type(4)));
typedef __bf16 bf16x2_t __attribute__((ext_vector_type(2)));
typedef GAS unsigned gu32;

__device__ __forceinline__ unsigned pk2(float lo, float hi) { f32x2 v = {lo, hi}; return __builtin_bit_cast(unsigned, __builtin_convertvector(v, bf16x2_t)); }
__device__ __forceinline__ float bflo(unsigned u) { return __uint_as_float(u << 16); }
__device__ __forceinline__ float bfhi(unsigned u) { return __uint_as_float(u & 0xffff0000u); }
__device__ __forceinline__ void unpack8(const u32x4 v, float (&x)[8]) { x[0] = bflo(v.x); x[1] = bfhi(v.x); x[2] = bflo(v.y); x[3] = bfhi(v.y); x[4] = bflo(v.z); x[5] = bfhi(v.z); x[6] = bflo(v.w); x[7] = bfhi(v.w); }
__device__ __forceinline__ float fexp2(float x) { return __builtin_amdgcn_exp2f(x); }
__device__ __forceinline__ float frcp(float x) { return __builtin_amdgcn_rcpf(x); }
#define LOG2E 1.4426950408889634f

constexpr int BATCH = 2, SEQ = 8192, D = 1024, M = BATCH * SEQ;
constexpr int LW = 1280, LH = 5, LB = 256;
constexpr int FF = 2816;
constexpr int NH = 8, NKV = 4, HD = 128, BLK = 256, NB = SEQ / BLK;
constexpr float RMS_EPS = 1e-6f;

namespace pg8 {
constexpr int BM = 256, BK = 64, HALF = 128, HTB = HALF * BK * 2, STAGE_BYTES = 8 * HTB, NXCD = 8, WGM = 8;
__host__ __device__ __forceinline__ int lds_byte(int r, int c) { const int st = (r >> 4) * 2 + (c >> 5), rr = r & 15, cc = c & 31, ob = rr * 64 + cc * 2; return st * 1024 + (ob ^ (((ob >> 9) & 1) << 5)); }
__host__ __device__ __forceinline__ void stage_rc(int b, int& R, int& C) { const int st = b / 1024, sb = b % 1024, swz = sb ^ (((sb >> 9) & 1) << 5); R = (st >> 1) * 16 + swz / 64; C = (st & 1) * 32 + (swz % 64) / 2; }
__host__ __device__ __forceinline__ int perm32(int rho) { const int n = rho >> 4, i = rho & 15; return 8 * (i >> 2) + 4 * n + (i & 3); }

struct Unit { int pm, pn, acol, half; };
struct Gemm { const bf16* A; const bf16* Bt; int M, N, K, lda; };

struct StaticOrder {
    int nM, nN, nwg, G, c;
    __device__ void init(int M_, int N_, int G_, int c_) { nM = M_ / BM; nN = N_ / BM; nwg = nM * nN; G = G_; c = c_; }
    __device__ void map(int L, Unit& u) const {
        int wgid = L; { const int q = nwg / NXCD, r = nwg % NXCD, xcd = wgid % NXCD, off = wgid / NXCD; wgid = (xcd < r ? xcd * (q + 1) : r * (q + 1) + (xcd - r) * q) + off; }
        const int nig = WGM * nN, gid = wgid / nig, fm = gid * WGM, gsz = (nM - fm) < WGM ? (nM - fm) : WGM;
        u.pm = fm + ((wgid % nig) % gsz); u.pn = (wgid % nig) / gsz; u.acol = 0; u.half = 0;
    }
    __device__ bool next(int i, Unit& u) const { const long L = (long)i * G + c; if (L >= nwg) return false; map((int)L, u); return true; }
};
struct TailSplitOrder {
    StaticOrder S; int full, split;
    __device__ void init(int M_, int N_, int G_, int c_) { S.init(M_, N_, G_, c_); full = S.nwg / G_; const int rem = S.nwg - full * G_; split = (full >= 1 && rem > 0 && 2 * rem == G_ && (G_ % (2 * NXCD)) == 0) ? 1 : 0; }
    __device__ bool next(int i, Unit& u) const {
        if (!split || i < full) return S.next(i, u);
        if (i > full) return false;
        const int xcd = S.c % NXCD, idx = S.c / NXCD;
        S.map(full * S.G + (idx >> 1) * NXCD + xcd, u); u.half = 1 + (idx & 1); return true;
    }
};
struct GatesOrder {
    int G, c;
    __device__ bool next(int i, Unit& u) const { const int L = i * G + c; if (L >= 640) return false; u.pm = L / 10; u.pn = L - 10 * u.pm; u.acol = (u.pn >> 1) * 256; u.half = 0; return true; }
};

template <class Epi, class Sched, bool ALIGN_EPI>
__device__ __forceinline__ void gemm_phase(LAS unsigned char* lds, const Gemm g, const Sched& S, const Epi& E) {
    int tid_ = threadIdx.x; asm volatile("" : "+v"(tid_));
    const int tid = tid_, wid = __builtin_amdgcn_readfirstlane(tid >> 6), lane = tid & 63, wr = wid >> 2, wc = wid & 3, fr = lane & 15, fq = lane >> 4;
    int K_ = g.K, lda_ = g.lda; asm volatile("" : "+s"(K_), "+s"(lda_));
    const int K = K_, nt = K / BK, lda = lda_;
    unsigned voffA[2], voffB[2];
#pragma unroll
    for (int i = 0; i < 2; ++i) { int R, C; stage_rc(tid * 16 + i * 8192, R, C); const int Rb = Epi::PERM ? ((R & ~31) + perm32(R & 31)) : R;
        const int Ra = Epi::AROWPERM ? (8 * (16 * (R >> 6) + (R & 15)) + ((R >> 4) & 3)) : R;
        voffA[i] = (unsigned)(Ra * lda + C) * 2u; voffB[i] = (unsigned)(Rb * K + C) * 2u; }
    const size_t kstep = (size_t)(BK * 2);
    const size_t hsA = (size_t)(Epi::AROWPERM ? 4 : HALF) * lda * 2, hsB = (size_t)HALF * K * 2;
    const size_t tsA = (size_t)BM * lda * 2, tsB = 2 * hsB;
    const unsigned ldsw = (unsigned)wid * 1024u;
    const int aoff = lds_byte(wr * 64 + fr, fq * 8), boff = lds_byte(wc * 32 + fr, fq * 8);
#define PG8_SA(b, h) (((b) * 2 + (h)) * HTB)
#define PG8_SB(b, h) ((4 + (b) * 2 + (h)) * HTB)
#define PG8_STAGE(bufoff, gbase, voff) do { _Pragma("unroll") for (int _i = 0; _i < 2; ++_i) \
        __builtin_amdgcn_global_load_lds((const unsigned*)((const char*)(gbase) + (voff)[_i]), (LAS unsigned*)(lds + (bufoff) + ldsw + _i * 8192), 16, 0, 0); } while (0)
#define PG8_LDA(dst, b, h) do { _Pragma("unroll") for (int m = 0; m < 4; ++m) _Pragma("unroll") for (int k = 0; k < 2; ++k) dst[m][k] = *(const LAS bf16x8*)(lds + PG8_SA(b, h) + aoff + m * 2048 + k * 1024); } while (0)
#define PG8_LDB(dst, b, h) do { _Pragma("unroll") for (int n = 0; n < 2; ++n) _Pragma("unroll") for (int k = 0; k < 2; ++k) dst[n][k] = *(const LAS bf16x8*)(lds + PG8_SB(b, h) + boff + n * 2048 + k * 1024); } while (0)
#define PG8_MMA(ai, bj, At, Bt) do { __builtin_amdgcn_s_setprio(1); _Pragma("unroll") for (int m = 0; m < 4; ++m) _Pragma("unroll") for (int n = 0; n < 2; ++n) _Pragma("unroll") for (int k = 0; k < 2; ++k) \
        acc[ai][bj][m][n] = __builtin_amdgcn_mfma_f32_16x16x32_bf16(Bt[n][k], At[m][k], acc[ai][bj][m][n], 0, 0, 0); __builtin_amdgcn_s_setprio(0); } while (0)
#define PG8_WAIT_V(n) asm volatile("s_waitcnt vmcnt(" #n ")" ::: "memory")
#define PG8_WAIT_L(n) asm volatile("s_waitcnt lgkmcnt(" #n ")" ::: "memory")
#define PG8_BAR __builtin_amdgcn_s_barrier()
#define PG8_SCHED __builtin_amdgcn_sched_barrier(0)
    Unit cur, nxt; int ui = 0;
    if (!S.next(0, cur)) return;
    f32x4 acc[2][2][4][2];
#pragma unroll
    for (int a = 0; a < 2; ++a)
#pragma unroll
        for (int b = 0; b < 2; ++b)
#pragma unroll
            for (int m = 0; m < 4; ++m)
#pragma unroll
                for (int n = 0; n < 2; ++n) acc[a][b][m][n] = (f32x4){0.f, 0.f, 0.f, 0.f};
    bf16x8 At[4][2], B0[2][2], B1[2][2];
    const char* cA = (const char*)g.A + (size_t)cur.pm * tsA + (size_t)cur.acol * 2 + (cur.half == 2 ? hsA : (size_t)0); const char* cB = (const char*)g.Bt + (size_t)cur.pn * tsB;
    bool fullu = cur.half == 0;
    PG8_STAGE(PG8_SB(0, 0), cB, voffB); PG8_STAGE(PG8_SB(0, 1), cB + hsB, voffB); PG8_STAGE(PG8_SA(0, 0), cA, voffA); PG8_STAGE(PG8_SA(0, 1), cA + hsA, voffA);
    if (wr == 1) PG8_BAR;
    PG8_WAIT_V(2); PG8_BAR;
    PG8_STAGE(PG8_SB(1, 0), cB + kstep, voffB); PG8_STAGE(PG8_SA(1, 0), cA + kstep, voffA); PG8_STAGE(PG8_SB(1, 1), cB + hsB + kstep, voffB);
    PG8_WAIT_V(6); PG8_BAR;
    for (;;) {
        const bool has_next = S.next(ui + 1, nxt);
        const char* nA = has_next ? (const char*)g.A + (size_t)nxt.pm * tsA + (size_t)nxt.acol * 2 + (nxt.half == 2 ? hsA : (size_t)0) : cA; const char* nB = has_next ? (const char*)g.Bt + (size_t)nxt.pn * tsB : cB;
        if (fullu) {
        for (int t = 0; t < nt; t += 2) {
            const bool last = (t == nt - 2);
            const char* a1 = cA + (size_t)(t + 1) * kstep;
            const char* a2 = last ? nA : cA + (size_t)(t + 2) * kstep; const char* b2 = last ? nB : cB + (size_t)(t + 2) * kstep;
            const char* a3 = a2 + kstep; const char* b3 = b2 + kstep;
            PG8_LDB(B0, 0, 0); PG8_LDB(B1, 0, 1); PG8_SCHED; PG8_LDA(At, 0, 0); PG8_STAGE(PG8_SA(1, 1), a1 + hsA, voffA);
            PG8_WAIT_V(8); PG8_WAIT_L(0); PG8_BAR; PG8_MMA(0, 0, At, B0); PG8_MMA(0, 1, At, B1); PG8_BAR; PG8_SCHED;
            PG8_LDA(At, 0, 1); PG8_STAGE(PG8_SB(0, 0), b2, voffB); PG8_STAGE(PG8_SB(0, 1), b2 + hsB, voffB); PG8_STAGE(PG8_SA(0, 0), a2, voffA);
            PG8_WAIT_V(8); PG8_WAIT_L(0); PG8_BAR; PG8_MMA(1, 0, At, B0); PG8_MMA(1, 1, At, B1); PG8_BAR; PG8_SCHED;
            PG8_LDB(B0, 1, 0); PG8_LDB(B1, 1, 1); PG8_SCHED; PG8_LDA(At, 1, 0); PG8_STAGE(PG8_SA(0, 1), a2 + hsA, voffA);
            PG8_WAIT_V(8); PG8_WAIT_L(0); PG8_BAR; PG8_MMA(0, 0, At, B0); PG8_MMA(0, 1, At, B1); PG8_BAR; PG8_SCHED;
            PG8_LDA(At, 1, 1); PG8_STAGE(PG8_SB(1, 0), b3, voffB); PG8_STAGE(PG8_SB(1, 1), b3 + hsB, voffB); PG8_STAGE(PG8_SA(1, 0), a3, voffA);
            PG8_WAIT_V(8); PG8_WAIT_L(0); PG8_BAR; PG8_MMA(1, 0, At, B0); PG8_MMA(1, 1, At, B1); PG8_BAR; PG8_SCHED;
        }
        } else {
        for (int t = 0; t < nt; t += 2) {
            const bool last = (t == nt - 2);
            const char* a2 = last ? nA : cA + (size_t)(t + 2) * kstep; const char* b2 = last ? nB : cB + (size_t)(t + 2) * kstep;
            const char* a3 = a2 + kstep; const char* b3 = b2 + kstep;
            PG8_LDB(B0, 0, 0); PG8_LDB(B1, 0, 1); PG8_SCHED; PG8_LDA(At, 0, 0);
            PG8_WAIT_V(6); PG8_WAIT_L(0); PG8_BAR; PG8_MMA(0, 0, At, B0); PG8_MMA(0, 1, At, B1); PG8_BAR; PG8_SCHED;
            PG8_STAGE(PG8_SB(0, 0), b2, voffB); PG8_STAGE(PG8_SB(0, 1), b2 + hsB, voffB); PG8_STAGE(PG8_SA(0, 0), a2, voffA);
            PG8_WAIT_V(6); PG8_BAR; PG8_BAR; PG8_SCHED;
            PG8_LDB(B0, 1, 0); PG8_LDB(B1, 1, 1); PG8_SCHED; PG8_LDA(At, 1, 0);
            PG8_WAIT_V(6); PG8_WAIT_L(0); PG8_BAR; PG8_MMA(0, 0, At, B0); PG8_MMA(0, 1, At, B1); PG8_BAR; PG8_SCHED;
            PG8_STAGE(PG8_SB(1, 0), b3, voffB); PG8_STAGE(PG8_SB(1, 1), b3 + hsB, voffB); PG8_STAGE(PG8_SA(1, 0), a3, voffA);
            PG8_WAIT_V(6); PG8_BAR; PG8_BAR; PG8_SCHED;
        }
        }
        if constexpr (ALIGN_EPI) { if (wr == 0) PG8_BAR; }
        if constexpr (!Epi::AFTER_DRAIN) E(acc, cur, wr, wc, fr, fq);
        if (!has_next) break;
#pragma unroll
        for (int a = 0; a < 2; ++a)
#pragma unroll
            for (int b = 0; b < 2; ++b)
#pragma unroll
                for (int m = 0; m < 4; ++m)
#pragma unroll
                    for (int n = 0; n < 2; ++n) acc[a][b][m][n] = (f32x4){0.f, 0.f, 0.f, 0.f};
        cur = nxt; cA = nA; cB = nB; ++ui; fullu = cur.half == 0;
        if constexpr (ALIGN_EPI) { if (wr == 1) PG8_BAR; }
    }
    PG8_WAIT_V(0);
    if constexpr (!ALIGN_EPI) { if (wr == 0) PG8_BAR; }
    PG8_BAR;
    if constexpr (Epi::AFTER_DRAIN) E.fused(acc, cur, wr, wc, fr, fq, lds, wid, lane);
#undef PG8_SA
#undef PG8_SB
#undef PG8_STAGE
#undef PG8_LDA
#undef PG8_LDB
#undef PG8_MMA
#undef PG8_WAIT_V
#undef PG8_WAIT_L
#undef PG8_BAR
#undef PG8_SCHED
}

typedef f32x4 AccT[2][2][4][2];

struct EpiPlain {
    static constexpr bool PERM = true, AFTER_DRAIN = false, AROWPERM = false;
    bf16* O; int ldc; float scale; float* KMP;
    __device__ __forceinline__ void operator()(const AccT& acc, const Unit& u, int wr, int wc, int fr, int fq) const {
        const int row0 = u.pm * BM + wr * 64 + fr, col0 = u.pn * BM + wc * 32 + 8 * fq;
#pragma unroll
        for (int ai = 0; ai < 2; ++ai)
#pragma unroll
            for (int m = 0; m < 4; ++m) { bf16* rowp = O + (size_t)(row0 + ai * HALF + m * 16) * ldc + col0;
#pragma unroll
                for (int bj = 0; bj < 2; ++bj) { const f32x4 v0 = acc[ai][bj][m][0] * scale, v1 = acc[ai][bj][m][1] * scale;
                    u32x4 w; w.x = pk2(v0[0], v0[1]); w.y = pk2(v0[2], v0[3]); w.z = pk2(v1[0], v1[1]); w.w = pk2(v1[2], v1[3]);
                    *(u32x4*)(rowp + bj * HALF) = w; } }
        if (KMP) {
#pragma unroll
            for (int bj = 0; bj < 2; ++bj)
#pragma unroll
                for (int n = 0; n < 2; ++n) { f32x4 t = (f32x4){0.f, 0.f, 0.f, 0.f};
#pragma unroll
                    for (int ai = 0; ai < 2; ++ai)
#pragma unroll
                        for (int m = 0; m < 4; ++m) t = t + acc[ai][bj][m][n];
#pragma unroll
                    for (int j = 0; j < 4; ++j) { float v = t[j]; v += __shfl_xor(v, 1); v += __shfl_xor(v, 2); v += __shfl_xor(v, 4); v += __shfl_xor(v, 8); t[j] = v * (1.0f / BLK); }
                    if (fr == 0) *(f32x4*)(KMP + ((size_t)(wr * (M / BM) + u.pm) * (NKV * HD) + col0 + bj * HALF + 4 * n)) = t; }
        }
    }
};
__device__ __forceinline__ float gelu_tanh(float v) {
    const float u2 = v * (1.5957691216057308f + 0.07135481627260025f * v * v);
    return v * frcp(1.0f + fexp2(-u2 * LOG2E));
}
struct EpiInProj {
    static constexpr bool PERM = true, AFTER_DRAIN = false, AROWPERM = false;
    bf16* Y; bf16* XB;
    __device__ __forceinline__ void operator()(const AccT& acc, const Unit& u, int wr, int wc, int fr, int fq) const {
        const int row0 = u.pm * BM + wr * 64 + fr; int colt = u.pn * BM; const bool isy = colt < LW; bf16* base = isy ? Y : XB; if (!isy) colt -= LW;
        const int col0 = colt + wc * 32 + 8 * fq;
#pragma unroll
        for (int ai = 0; ai < 2; ++ai)
#pragma unroll
            for (int m = 0; m < 4; ++m) { bf16* rowp = base + (size_t)(row0 + ai * HALF + m * 16) * LW + col0;
#pragma unroll
                for (int bj = 0; bj < 2; ++bj) { f32x4 v0 = acc[ai][bj][m][0], v1 = acc[ai][bj][m][1];
                    if (isy) {
#pragma unroll
                        for (int j = 0; j < 4; ++j) { v0[j] = gelu_tanh(v0[j]); v1[j] = gelu_tanh(v1[j]); } }
                    u32x4 w; w.x = pk2(v0[0], v0[1]); w.y = pk2(v0[2], v0[3]); w.z = pk2(v1[0], v1[1]); w.w = pk2(v1[2], v1[3]);
                    *(u32x4*)(rowp + bj * HALF) = w; } }
    }
};

__device__ __forceinline__ float dpp_prev_lane(float v) { return __int_as_float(__builtin_amdgcn_update_dpp(0, __float_as_int(v), 0x111  , 0xf, 0xf, false)); }
struct EpiInProjConv {
    static constexpr bool PERM = true, AFTER_DRAIN = false, AROWPERM = true;
    bf16* Y; bf16* XC; bf16* RAWS; const float* cw; const float* cb;
    __device__ __forceinline__ void operator()(const AccT& acc, const Unit& u, int wr, int wc, int fr, int fq) const {
        const int t0 = u.pm * BM + 8 * (16 * wr + fr); int colt = u.pn * BM; const bool isy = colt < LW;
        if (isy) {
            const int col0 = colt + wc * 32 + 8 * fq;
#pragma unroll
            for (int ai = 0; ai < 2; ++ai)
#pragma unroll
                for (int m = 0; m < 4; ++m) { bf16* rowp = Y + (size_t)(t0 + 4 * ai + m) * LW + col0;
#pragma unroll
                    for (int bj = 0; bj < 2; ++bj) { f32x4 v0 = acc[ai][bj][m][0], v1 = acc[ai][bj][m][1];
#pragma unroll
                        for (int j = 0; j < 4; ++j) { v0[j] = gelu_tanh(v0[j]); v1[j] = gelu_tanh(v1[j]); }
                        u32x4 w; w.x = pk2(v0[0], v0[1]); w.y = pk2(v0[2], v0[3]); w.z = pk2(v1[0], v1[1]); w.w = pk2(v1[2], v1[3]);
                        *(u32x4*)(rowp + bj * HALF) = w; } }
            return;
        }
        colt -= LW;
#pragma unroll
        for (int bj = 0; bj < 2; ++bj) {
            const int ch0 = colt + bj * HALF + wc * 32 + 8 * fq;
            f32x4 w0[2], w1[2], w2[2], w3[2], bb[2];
#pragma unroll
            for (int n = 0; n < 2; ++n) { w0[n] = *(const f32x4*)(cw + ch0 + 4 * n); w1[n] = *(const f32x4*)(cw + LW + ch0 + 4 * n); w2[n] = *(const f32x4*)(cw + 2 * LW + ch0 + 4 * n); w3[n] = *(const f32x4*)(cw + 3 * LW + ch0 + 4 * n); bb[n] = *(const f32x4*)(cb + ch0 + 4 * n); }
            f32x4 p5[2], p6[2], p7[2];
#pragma unroll
            for (int n = 0; n < 2; ++n)
#pragma unroll
                for (int e = 0; e < 4; ++e) { p5[n][e] = dpp_prev_lane(acc[1][bj][1][n][e]); p6[n][e] = dpp_prev_lane(acc[1][bj][2][n][e]); p7[n][e] = dpp_prev_lane(acc[1][bj][3][n][e]); }
#pragma unroll
            for (int j = 0; j < 8; ++j) {
                f32x4 o[2];
#pragma unroll
                for (int n = 0; n < 2; ++n) {
                    const f32x4 x0 = acc[j >> 2][bj][j & 3][n];
                    const f32x4 xm1 = j >= 1 ? acc[(j - 1) >> 2][bj][(j - 1) & 3][n] : p7[n];
                    const f32x4 xm2 = j >= 2 ? acc[(j - 2) >> 2][bj][(j - 2) & 3][n] : (j == 1 ? p7[n] : p6[n]);
                    const f32x4 xm3 = j >= 3 ? acc[(j - 3) >> 2][bj][(j - 3) & 3][n] : (j == 2 ? p7[n] : (j == 1 ? p6[n] : p5[n]));
                    o[n] = bb[n] + w0[n] * xm3 + w1[n] * xm2 + w2[n] * xm1 + w3[n] * x0; }
                if (j >= 3 || fr != 0) { u32x4 w; w.x = pk2(o[0][0], o[0][1]); w.y = pk2(o[0][2], o[0][3]); w.z = pk2(o[1][0], o[1][1]); w.w = pk2(o[1][2], o[1][3]);
                    *(u32x4*)(XC + (size_t)(t0 + j) * LW + ch0) = w; }
                if ((j < 3 && fr == 0) || (j >= 5 && fr == 15)) { const f32x4 r0 = acc[j >> 2][bj][j & 3][0], r1 = acc[j >> 2][bj][j & 3][1];
                    u32x4 w; w.x = pk2(r0[0], r0[1]); w.y = pk2(r0[2], r0[3]); w.z = pk2(r1[0], r1[1]); w.w = pk2(r1[2], r1[3]);
                    *(u32x4*)(RAWS + (size_t)((u.pm * 2 + wr) * 6 + (j < 3 ? j : j - 2)) * LW + ch0) = w; }
            }
        }
    }
};
struct EpiGates {
    static constexpr bool PERM = true, AFTER_DRAIN = false, AROWPERM = true;
    const bf16* XC; bf16* LA; bf16* BBo; const float* bgr; const float* bgi; const float* c8; float* SA; float* SB;
    __device__ __forceinline__ void operator()(const AccT& acc, const Unit& u, int wr, int wc, int fr, int fq) const {
        const int t0 = u.pm * BM + 8 * (16 * wr + fr); const int ch0 = (u.pn >> 1) * 256 + (u.pn & 1) * 128 + wc * 32 + 8 * fq;
        float br[8], bi[8], cc[8];
#pragma unroll
        for (int j = 0; j < 8; ++j) { br[j] = -LOG2E * bgr[ch0 + j]; bi[j] = -LOG2E * bgi[ch0 + j]; cc[j] = c8[ch0 + j]; }
        float A[8], B[8];
#pragma unroll
        for (int e = 0; e < 8; ++e) { A[e] = 1.0f; B[e] = 0.0f; }
#pragma unroll
        for (int ai = 0; ai < 2; ++ai)
#pragma unroll
            for (int m = 0; m < 4; ++m) { const size_t off = (size_t)(t0 + 4 * ai + m) * LW + ch0;
                float xc[8]; unpack8(*(const u32x4*)(XC + off), xc);
                float la[8], ig[8];
#pragma unroll
                for (int n = 0; n < 2; ++n)
#pragma unroll
                    for (int j = 0; j < 4; ++j) { const int e = 4 * n + j;
                        const float r = frcp(1.0f + fexp2(acc[ai][0][m][n][j] * (-LOG2E) + br[e])); ig[e] = frcp(1.0f + fexp2(acc[ai][1][m][n][j] * (-LOG2E) + bi[e]));
                        la[e] = -cc[e] * r; }
                u32x4 wl; wl.x = pk2(la[0], la[1]); wl.y = pk2(la[2], la[3]); wl.z = pk2(la[4], la[5]); wl.w = pk2(la[6], la[7]);
                *(u32x4*)(LA + off) = wl;
                float lr[8]; unpack8(wl, lr);
                float av[8], bb[8];
#pragma unroll
                for (int e = 0; e < 8; ++e) { av[e] = fexp2(LOG2E * lr[e]); bb[e] = __builtin_amdgcn_sqrtf(1.0f - av[e] * av[e]) * (ig[e] * xc[e]); }
                u32x4 wb; wb.x = pk2(bb[0], bb[1]); wb.y = pk2(bb[2], bb[3]); wb.z = pk2(bb[4], bb[5]); wb.w = pk2(bb[6], bb[7]);
                *(u32x4*)(BBo + off) = wb;
                float bq[8]; unpack8(wb, bq);
#pragma unroll
                for (int e = 0; e < 8; ++e) { B[e] = av[e] * B[e] + bq[e]; A[e] *= av[e]; }
                asm volatile("" ::: "memory"); }
#pragma unroll
        for (int e = 0; e < 8; ++e) {
            float Ap = __int_as_float(__builtin_amdgcn_update_dpp(0, __float_as_int(A[e]), 0x111, 0xf, 0xf, false)), Bp = __int_as_float(__builtin_amdgcn_update_dpp(0, __float_as_int(B[e]), 0x111, 0xf, 0xf, false));
            B[e] = A[e] * Bp + B[e]; A[e] = Ap * A[e];
            Ap = __int_as_float(__builtin_amdgcn_update_dpp(0, __float_as_int(A[e]), 0x112, 0xf, 0xf, false)); Bp = __int_as_float(__builtin_amdgcn_update_dpp(0, __float_as_int(B[e]), 0x112, 0xf, 0xf, false));
            B[e] = A[e] * Bp + B[e]; A[e] = Ap * A[e]; }
        if ((fr & 3) == 3) { const size_t so = (size_t)(u.pm * 8 + wr * 4 + (fr >> 2)) * LW + ch0;
            *(f32x4*)(SA + so) = (f32x4){A[0], A[1], A[2], A[3]}; *(f32x4*)(SA + so + 4) = (f32x4){A[4], A[5], A[6], A[7]};
            *(f32x4*)(SB + so) = (f32x4){B[0], B[1], B[2], B[3]}; *(f32x4*)(SB + so + 4) = (f32x4){B[4], B[5], B[6], B[7]}; }
    }
};
struct EpiSwiGLU {
    static constexpr bool PERM = true, AFTER_DRAIN = false, AROWPERM = false;
    bf16* HF;
    __device__ __forceinline__ void operator()(const AccT& acc, const Unit& u, int wr, int wc, int fr, int fq) const {
        const int row0 = u.pm * BM + (u.half == 2 ? HALF : 0) + wr * 64 + fr, col0 = u.pn * HALF + wc * 32 + 8 * fq;
#pragma unroll
        for (int ai = 0; ai < 2; ++ai) { if (ai == 1 && u.half) break;
#pragma unroll
            for (int m = 0; m < 4; ++m) { float o[8];
#pragma unroll
                for (int n = 0; n < 2; ++n)
#pragma unroll
                    for (int j = 0; j < 4; ++j) { const float gt = acc[ai][0][m][n][j], up = acc[ai][1][m][n][j]; o[4 * n + j] = gt * frcp(1.0f + fexp2(-gt * LOG2E)) * up; }
                u32x4 w; w.x = pk2(o[0], o[1]); w.y = pk2(o[2], o[3]); w.z = pk2(o[4], o[5]); w.w = pk2(o[6], o[7]);
                *(u32x4*)(HF + (size_t)(row0 + ai * HALF + m * 16) * FF + col0) = w; } }
    }
};
struct EpiResid {
    static constexpr bool PERM = true, AFTER_DRAIN = false, AROWPERM = false;
    const void* resid; void* out; const float* gv; int gstride; int rbf, obf;
    __device__ __forceinline__ void operator()(const AccT& acc, const Unit& u, int wr, int wc, int fr, int fq) const {
        const int row0 = u.pm * BM + wr * 64 + fr, col0 = u.pn * BM + wc * 32 + 8 * fq; const float* gp = gv + (size_t)(u.pm >> 5) * gstride + col0;
        f32x4 gg[2][2];
#pragma unroll
        for (int bj = 0; bj < 2; ++bj)
#pragma unroll
            for (int n = 0; n < 2; ++n) gg[bj][n] = *(const f32x4*)(gp + bj * HALF + 4 * n);
#pragma unroll
        for (int ai = 0; ai < 2; ++ai)
#pragma unroll
            for (int m = 0; m < 4; ++m) { const size_t off = (size_t)(row0 + ai * HALF + m * 16) * D + col0;
#pragma unroll
                for (int bj = 0; bj < 2; ++bj) { const size_t o = off + bj * HALF; f32x4 r0, r1;
                    if (rbf) { const u32x4 w = *(const u32x4*)((const bf16*)resid + o); r0 = (f32x4){bflo(w.x), bfhi(w.x), bflo(w.y), bfhi(w.y)}; r1 = (f32x4){bflo(w.z), bfhi(w.z), bflo(w.w), bfhi(w.w)}; }
                    else { r0 = __builtin_nontemporal_load((const f32x4*)((const float*)resid + o)); r1 = __builtin_nontemporal_load((const f32x4*)((const float*)resid + o + 4)); }
                    const f32x4 x0 = r0 + gg[bj][0] * acc[ai][bj][m][0], x1 = r1 + gg[bj][1] * acc[ai][bj][m][1];
                    if (obf) { u32x4 w; w.x = pk2(x0[0], x0[1]); w.y = pk2(x0[2], x0[3]); w.z = pk2(x1[0], x1[1]); w.w = pk2(x1[2], x1[3]); *(u32x4*)((bf16*)out + o) = w; }
                    else { *(f32x4*)((float*)out + o) = x0; *(f32x4*)((float*)out + o + 4) = x1; } } }
    }
};

struct RowSumSq {
    unsigned long long* xbuf;
    unsigned* cnt;
    unsigned* tmo;
    __device__ __forceinline__ bool run(const AccT& v, const Unit& u, int wr, int wc, int fr, int fq, LAS unsigned char* lds, int wid, int lane) const {
        LAS float* P = (LAS float*)lds;
        LAS float* S = (LAS float*)(lds + 8192);
        LAS unsigned* flag = (LAS unsigned*)(lds + 8192 + 2048);
#pragma unroll
        for (int ai = 0; ai < 2; ++ai)
#pragma unroll
            for (int m = 0; m < 4; ++m) { float q = 0.f;
#pragma unroll
                for (int bj = 0; bj < 2; ++bj)
#pragma unroll
                    for (int n = 0; n < 2; ++n) { const f32x4 x = v[ai][bj][m][n]; q += (x[0] * x[0] + x[1] * x[1]) + (x[2] * x[2] + x[3] * x[3]); }
                q += __shfl_xor(q, 16); q += __shfl_xor(q, 32);
                if (fq == 0) P[(ai * HALF + wr * 64 + m * 16 + fr) * 4 + wc] = q; }
        asm volatile("s_waitcnt lgkmcnt(0)" ::: "memory"); __builtin_amdgcn_s_barrier(); asm volatile("" ::: "memory");
        const int row = wid * 32 + (lane & 31);
        unsigned* xs = (unsigned*)xbuf;
        if (lane < 32) { const float t = (P[row * 4 + 0] + P[row * 4 + 1]) + (P[row * 4 + 2] + P[row * 4 + 3]);
            __hip_atomic_store(xs + ((unsigned)(u.pm * BM + row) * 4u + (unsigned)u.pn), __float_as_uint(t) | 0x80000000u, __ATOMIC_RELAXED, __HIP_MEMORY_SCOPE_AGENT); }
        float q = 0.f; bool dead = false;
#pragma nounroll
        for (unsigned sp = 0;; ++sp) {
            bool ok = true;
            if (lane < 32) { const unsigned long long* sl = (const unsigned long long*)(xs + (unsigned)(u.pm * BM + row) * 4u);
                const unsigned long long a01 = __hip_atomic_load(sl, __ATOMIC_RELAXED, __HIP_MEMORY_SCOPE_AGENT), a23 = __hip_atomic_load(sl + 1, __ATOMIC_RELAXED, __HIP_MEMORY_SCOPE_AGENT);
                const unsigned w0 = (unsigned)a01, w1 = (unsigned)(a01 >> 32), w2 = (unsigned)a23, w3 = (unsigned)(a23 >> 32);
                ok = ((w0 & w1 & w2 & w3) >> 31) != 0u;
                q = (__uint_as_float(w0 & 0x7fffffffu) + __uint_as_float(w1 & 0x7fffffffu)) + (__uint_as_float(w2 & 0x7fffffffu) + __uint_as_float(w3 & 0x7fffffffu)); }
            if (__all(ok)) break;
            if (sp > 20000u) { if (lane == 0) __hip_atomic_store(tmo, 1u, __ATOMIC_RELAXED, __HIP_MEMORY_SCOPE_AGENT); dead = true; break; }
            __builtin_amdgcn_s_sleep(1);
        }
        const bool bad = false;
        if (lane < 32) S[row] = dead ? __builtin_nanf("") : 1.0f / sqrtf(q * (1.0f / D) + RMS_EPS);
        asm volatile("s_waitcnt lgkmcnt(0)" ::: "memory"); __builtin_amdgcn_s_barrier(); asm volatile("" ::: "memory");
        return bad;
    }
};
struct EpiResidNorm {
    static constexpr bool PERM = true, AFTER_DRAIN = true, AROWPERM = false;
    const void* resid; int rbf; bf16* XS; const float* gv; int gstride; RowSumSq st;
    int final_; float* OUT;
    int nout; bf16* H0; const float* g0; const float* sh0; const float* sc0; int bs0; bf16* H1; const float* g1; const float* sh1; const float* sc1; int bs1;
    __device__ __forceinline__ void fused(AccT& acc, const Unit& u, int wr, int wc, int fr, int fq, LAS unsigned char* lds, int wid, int lane) const {
        const int row0 = u.pm * BM + wr * 64 + fr, col0 = u.pn * BM + wc * 32 + 8 * fq, b = u.pm >> 5; const float* gp = gv + (size_t)b * gstride + col0;
#pragma unroll
        for (int bj = 0; bj < 2; ++bj) { const f32x4 ga = *(const f32x4*)(gp + bj * HALF), gb = *(const f32x4*)(gp + bj * HALF + 4);
#define ERN_APPLY(q_, r0_, r1_) do { const int ai = (q_) >> 2, m = (q_) & 3; const size_t o = (size_t)(row0 + ai * HALF + m * 16) * D + col0 + bj * HALF; \
                const f32x4 x0 = (r0_) + ga * acc[ai][bj][m][0], x1 = (r1_) + gb * acc[ai][bj][m][1]; acc[ai][bj][m][0] = x0; acc[ai][bj][m][1] = x1; \
                if (!final_) { u32x4 w; w.x = pk2(x0[0], x0[1]); w.y = pk2(x0[2], x0[3]); w.z = pk2(x1[0], x1[1]); w.w = pk2(x1[2], x1[3]); *(u32x4*)(XS + o) = w; } } while (0)
            if (rbf) {
                u32x4 rw[8];
#pragma unroll
                for (int q = 0; q < 8; ++q) rw[q] = *(const u32x4*)((const bf16*)resid + ((size_t)(row0 + (q >> 2) * HALF + (q & 3) * 16) * D + col0 + bj * HALF));
#pragma unroll
                for (int q = 0; q < 8; ++q) { const u32x4 w = rw[q]; const f32x4 r0 = (f32x4){bflo(w.x), bfhi(w.x), bflo(w.y), bfhi(w.y)}, r1 = (f32x4){bflo(w.z), bfhi(w.z), bflo(w.w), bfhi(w.w)}; ERN_APPLY(q, r0, r1); }
            } else {
#pragma unroll
                for (int hq = 0; hq < 2; ++hq) { f32x4 ra[4], rb[4];
#pragma unroll
                    for (int k = 0; k < 4; ++k) { const int q = 4 * hq + k; const size_t o = (size_t)(row0 + (q >> 2) * HALF + (q & 3) * 16) * D + col0 + bj * HALF;
                        ra[k] = __builtin_nontemporal_load((const f32x4*)((const float*)resid + o)); rb[k] = __builtin_nontemporal_load((const f32x4*)((const float*)resid + o + 4)); }
#pragma unroll
                    for (int k = 0; k < 4; ++k) ERN_APPLY(4 * hq + k, ra[k], rb[k]); }
            }
#undef ERN_APPLY
        }
        __builtin_amdgcn_sched_barrier(0);
        f32x4 KA[2], KB[2], SA_[2], SB_[2];
#pragma unroll
        for (int bj = 0; bj < 2; ++bj) { const int c = col0 + bj * HALF;
            f32x4 ka = *(const f32x4*)(g0 + c), kb = *(const f32x4*)(g0 + c + 4), sa = (f32x4){0.f, 0.f, 0.f, 0.f}, sb = sa;
            if (!final_) { ka = ka * (*(const f32x4*)(sc0 + (size_t)b * bs0 + c) + 1.0f); kb = kb * (*(const f32x4*)(sc0 + (size_t)b * bs0 + c + 4) + 1.0f); sa = *(const f32x4*)(sh0 + (size_t)b * bs0 + c); sb = *(const f32x4*)(sh0 + (size_t)b * bs0 + c + 4); }
            KA[bj] = ka; KB[bj] = kb; SA_[bj] = sa; SB_[bj] = sb; }
        const bool bad = st.run(acc, u, wr, wc, fr, fq, lds, wid, lane);
        const LAS float* S = (const LAS float*)(lds + 8192);
        const float qnan = __builtin_nanf("");
#pragma unroll
        for (int bj = 0; bj < 2; ++bj) { const int c = col0 + bj * HALF;
            const f32x4 ka = KA[bj], kb = KB[bj], sa = SA_[bj], sb = SB_[bj]; f32x4 la, lb, ta, tb;
            if (nout == 2) { la = *(const f32x4*)(g1 + c) * (*(const f32x4*)(sc1 + (size_t)b * bs1 + c) + 1.0f); lb = *(const f32x4*)(g1 + c + 4) * (*(const f32x4*)(sc1 + (size_t)b * bs1 + c + 4) + 1.0f);
                             ta = *(const f32x4*)(sh1 + (size_t)b * bs1 + c); tb = *(const f32x4*)(sh1 + (size_t)b * bs1 + c + 4); }
#pragma unroll
            for (int ai = 0; ai < 2; ++ai)
#pragma unroll
                for (int m = 0; m < 4; ++m) { const int r = ai * HALF + wr * 64 + m * 16 + fr; const float rs = bad ? qnan : S[r]; const size_t o = (size_t)(u.pm * BM + r) * D + c;
                    const f32x4 x0 = acc[ai][bj][m][0] * rs, x1 = acc[ai][bj][m][1] * rs;
                    if (final_) { __builtin_nontemporal_store(x0 * ka, (f32x4*)(OUT + o)); __builtin_nontemporal_store(x1 * kb, (f32x4*)(OUT + o + 4)); }
                    else { const f32x4 y0 = x0 * ka + sa, y1 = x1 * kb + sb; u32x4 w; w.x = pk2(y0[0], y0[1]); w.y = pk2(y0[2], y0[3]); w.z = pk2(y1[0], y1[1]); w.w = pk2(y1[2], y1[3]); *(u32x4*)(H0 + o) = w;
                        if (nout == 2) { const f32x4 z0 = x0 * la + ta, z1 = x1 * lb + tb; u32x4 w2; w2.x = pk2(z0[0], z0[1]); w2.y = pk2(z0[2], z0[3]); w2.z = pk2(z1[0], z1[1]); w2.w = pk2(z1[2], z1[3]); *(u32x4*)(H1 + o) = w2; } } } }
    }
};
}

constexpr size_t MiB = 1u << 20;
constexpr size_t WS_CTL = 0, CTL_ZERO_BYTES = 4 * MiB;
constexpr int CW_TMO = 0, CW_TMO_X = 2, CW_BAR = 4096, CW_LCNT = 16384, CW_SEAM = 32768;
constexpr size_t WS_RAWS = 5 * MiB;
constexpr size_t WS_KMP = 4 * MiB;
constexpr size_t WS_XCHG = 2 * MiB;
constexpr size_t WS_MOD0 = 1 * MiB, WS_MOD1 = WS_MOD0 + 65536, WS_KVMOD = WS_MOD1 + 65536, WS_C8 = WS_KVMOD + 32768, WS_KM = WS_C8 + 8192;
constexpr size_t WS_SA = 250 * MiB, WS_SB = 253 * MiB;
constexpr size_t WS_ML = 5 * MiB;
constexpr size_t WS_WIN = 8 * MiB, WS_WG = 13 * MiB, WS_WOUT = 15 * MiB, WS_WKV = 18 * MiB, WS_WQ = 20 * MiB, WS_WO = 22 * MiB;
constexpr size_t WS_WGU0 = 24 * MiB, WS_WGU1 = 35 * MiB, WS_WD0 = 46 * MiB, WS_WD1 = 52 * MiB;
constexpr size_t ACT = 58 * MiB;
constexpr size_t WS_H_L0 = ACT, WS_Y = ACT + 32 * MiB, WS_XB = ACT + 72 * MiB, WS_XC = ACT + 112 * MiB, WS_BB = ACT + 152 * MiB;
constexpr size_t WS_H_F0 = ACT, WS_HF0 = ACT + 32 * MiB;
constexpr size_t WS_XS = 224 * MiB;
constexpr size_t DO_QB = 0, DO_KB = 32 * MiB, DO_VT = 48 * MiB;
constexpr size_t WS_LIST = ACT, WS_OP = ACT + 16 * MiB;
constexpr size_t WS_HKV = ACT, WS_H_L1 = 178 * MiB;
constexpr size_t WS_H_F1 = ACT + 112 * MiB, WS_HF1 = ACT;
constexpr size_t WS_END = 256 * MiB;
constexpr int LIST_CAP = 16384;

constexpr int RING_OFF = 0, RING_BYTES = 131072;
constexpr int LDSCTL_OFF = RING_BYTES, MISC_OFF = LDSCTL_OFF + 320;
constexpr int BT_OFF = LDSCTL_OFF + 512;
constexpr int PRE_OFF = BT_OFF + 4096;
constexpr int LDS_BYTES = 147456;
static_assert(PRE_OFF + 2048 <= LDS_BYTES, "LDS map");

#define RLX_AGENT __ATOMIC_RELAXED, __HIP_MEMORY_SCOPE_AGENT
#define LDS_WAIT() asm volatile("s_waitcnt lgkmcnt(0)" ::: "memory")

#define XB_TMO      128
#define XB_XCNT(j)  (256  + 64 * (j))
#define XB_XSUB(j)  (1280 + 64 * (j))
#define XB_XGEN(j)  (2304 + 64 * (j))
#define XB_TOP      3328
#define XB_TOPGEN   3392
#define XCD_BAR_WORDS 3456
#define XB_SPIN_CAP (1u << 18)
__device__ __forceinline__ unsigned xb_ld(unsigned* p)              { return __hip_atomic_load(p, __ATOMIC_RELAXED, __HIP_MEMORY_SCOPE_AGENT); }
__device__ __forceinline__ unsigned xb_add(unsigned* p, unsigned v) { return __hip_atomic_fetch_add(p, v, __ATOMIC_RELAXED, __HIP_MEMORY_SCOPE_AGENT); }
__device__ __forceinline__ unsigned xb_xcc_id() { return (unsigned)__builtin_amdgcn_s_getreg((3 << 11) | 20) & 0xFu; }
#define XB_SPIN(cond, bar) do { unsigned _sp = 0; while (cond) { __builtin_amdgcn_s_sleep(1); \
    if ((++_sp & 255u) == 0u) { if (xb_ld(&(bar)[XB_TMO])) break; if (_sp > XB_SPIN_CAP) { atomicAdd(&(bar)[XB_TMO], 1u); break; } } } } while (0)
struct XcdBarrier { unsigned* bar; unsigned x; volatile LAS unsigned* st; };
__device__ __forceinline__ XcdBarrier xcd_barrier_post(unsigned* bar, volatile LAS unsigned* st) {
    XcdBarrier b; b.bar = bar; b.x = xb_xcc_id(); b.st = st;
    if (threadIdx.x == 0) (void)xb_add(&bar[XB_XCNT(b.x)], 1u);
    return b;
}
__device__ __forceinline__ void xcd_barrier_complete(unsigned* bar, unsigned x, unsigned& nloc, unsigned& nx) {
    const unsigned G = gridDim.x * gridDim.y * gridDim.z;
    unsigned sum, cnt, mine, sp = 0u;
    for (;;) {
        sum = 0u; cnt = 0u; mine = 0u;
#pragma nounroll
        for (unsigned j = 0; j < 16; ++j) { const unsigned c = xb_ld(&bar[XB_XCNT(j)]); sum += c; cnt += (c > 0u) ? 1u : 0u; mine = (j == x) ? c : mine; }
        if (sum == G) break;
        __builtin_amdgcn_s_sleep(1);
        if ((++sp & 255u) == 0u) { if (xb_ld(&bar[XB_TMO])) break; if (sp > XB_SPIN_CAP) { atomicAdd(&bar[XB_TMO], 1u); break; } }
    }
    nloc = mine > 0u ? mine : 1u; nx = cnt > 0u ? cnt : 1u;
}
__device__ __forceinline__ void xcd_barrier(const XcdBarrier& b) {
    asm volatile("s_waitcnt vmcnt(0)" ::: "memory");
    __syncthreads();
    int tid0_ = threadIdx.x; asm volatile("" : "+v"(tid0_));
    if (tid0_ == 0) {
        unsigned* bar = b.bar;
        __builtin_amdgcn_s_waitcnt(0);
        unsigned nloc = b.st[0], nx = b.st[1];
        if (nloc == 0u) { xcd_barrier_complete(bar, b.x, nloc, nx); b.st[0] = nloc; b.st[1] = nx; }
        const unsigned old = xb_add(&bar[XB_XSUB(b.x)], 1u);
        const unsigned gen = old / nloc;
        if (old + 1u == (gen + 1u) * nloc) {
            __builtin_amdgcn_fence(__ATOMIC_RELEASE, "agent");
            asm volatile("s_waitcnt vmcnt(0)" ::: "memory");
            const unsigned og = xb_add(&bar[XB_TOP], 1u);
            const unsigned tg = og / nx;
            if (og + 1u == (tg + 1u) * nx) xb_add(&bar[XB_TOPGEN], 1u);
            else XB_SPIN(xb_ld(&bar[XB_TOPGEN]) == tg, bar);
            __builtin_amdgcn_fence(__ATOMIC_ACQUIRE, "agent");
            xb_add(&bar[XB_XGEN(b.x)], 1u);
            asm volatile("s_waitcnt vmcnt(0)" ::: "memory");
        } else {
            XB_SPIN(xb_ld(&bar[XB_XGEN(b.x)]) == gen, bar);
            __builtin_amdgcn_fence(__ATOMIC_ACQUIRE, "agent");
            asm volatile("s_waitcnt vmcnt(0)" ::: "memory");
        }
    }
    __syncthreads();
}

struct Args { const float* in[24]; float* out; unsigned char* ws; int ph_lo, ph_hi; };
static_assert(offsetof(Args, out) == 192 && offsetof(Args, ws) == 200, "kernarg layout");
struct Frame {
    LAS unsigned char* lds;
    int tid, lane, wave, G, bid, dry;
    const __attribute__((address_space(4))) unsigned char* kp; float* out; unsigned char* ws;
};
#define CAS __attribute__((address_space(4)))
#define ARG_IN(F, i) (((const float* const CAS*)(F).kp)[(i)])
enum { I_X = 0, I_C, I_MODW, I_MODB, I_NMIX, I_NFFN, I_WIN, I_CONVW, I_CONVB, I_WGATES, I_BGATES, I_LAMBDA, I_WOUT, I_KVMODW, I_KVMODB, I_KVNORM, I_WKV, I_WQ, I_WO, I_RELB, I_FGATE, I_FUP, I_FDOWN, I_FNORM };

__device__ __forceinline__ void fresh_ids(Frame& F) {
    int t = threadIdx.x; asm volatile("" : "+v"(t)); F.tid = t; F.lane = t & 63; F.wave = __builtin_amdgcn_readfirstlane(t >> 6);
    const CAS unsigned char* kp = (const CAS unsigned char*)__builtin_amdgcn_kernarg_segment_ptr(); asm volatile("" : "+s"(kp)); F.kp = kp;
    F.out = *(float* const CAS*)(kp + 192); F.ws = *(unsigned char* const CAS*)(kp + 200);
    int g = gridDim.x; asm volatile("" : "+s"(g)); F.G = g;
    int bx = blockIdx.x; asm volatile("" : "+s"(bx)); F.bid = bx;
}
__device__ __forceinline__ float wave_sum(float v) {
#pragma unroll
    for (int o = 1; o < 64; o <<= 1) v += __shfl_xor(v, o);
    return v;
}

__device__ __forceinline__ void p_modgemv(Frame& F) {
    LAS float* cs = (LAS float*)(F.lds + RING_OFF);
    LAS float* red = cs + 2048;
    for (int i = F.tid; i < 2048; i += 512) { const float c = ARG_IN(F, I_C)[i]; cs[i] = c * frcp(1.0f + fexp2(-c * LOG2E)); }
    __syncthreads();
    for (int it = F.bid; it < 224; it += F.G) {
        const float* W; const float* bias; float* out; int N, g;
        if (it < 96) { W = ARG_IN(F, I_MODW); N = 6 * D; g = it; bias = ARG_IN(F, I_MODB); out = (float*)(F.ws + WS_MOD0); }
        else if (it < 192) { W = ARG_IN(F, I_MODW) + (size_t)D * 6 * D; N = 6 * D; g = it - 96; bias = ARG_IN(F, I_MODB) + 6 * D; out = (float*)(F.ws + WS_MOD1); }
        else { W = ARG_IN(F, I_KVMODW); N = 2 * D; g = it - 192; bias = ARG_IN(F, I_KVMODB); out = (float*)(F.ws + WS_KVMOD); }
        const int col = g * 64 + F.lane; const int k0 = 128 * F.wave;
        const float* wp = W + (size_t)k0 * N + col;
        float a0 = 0.f, a1 = 0.f;
#pragma unroll 16
        for (int j = 0; j < 128; ++j) { const float w = __builtin_nontemporal_load(wp + (size_t)j * N); a0 += cs[k0 + j] * w; a1 += cs[1024 + k0 + j] * w; }
        red[(F.wave * 2 + 0) * 64 + F.lane] = a0; red[(F.wave * 2 + 1) * 64 + F.lane] = a1;
        __syncthreads();
        if (F.tid < 128) { const int b = F.tid >> 6, l = F.tid & 63; float s = 0.f;
#pragma unroll
            for (int w = 0; w < 8; ++w) s += red[(w * 2 + b) * 64 + l];
            out[(size_t)b * N + g * 64 + l] = s + bias[g * 64 + l]; }
        __syncthreads();
    }
}
struct TItem { const float* src; bf16* dst; int N, K, k0, n0, drow0; };
__device__ __forceinline__ void ti_load(const TItem& t, float (&wv)[32], int lane) {
#pragma unroll
    for (int i = 0; i < 32; ++i) wv[i] = __builtin_nontemporal_load(t.src + (size_t)(t.k0 + 2 * i + (lane >> 5)) * t.N + t.n0 + (lane & 31));
}
__device__ __forceinline__ void ti_store(const TItem& t, const float (&wv)[32], LAS float* scr, int lane) {
#pragma unroll
    for (int i = 0; i < 32; ++i) scr[(2 * i + (lane >> 5)) * 33 + (lane & 31)] = wv[i];
    LDS_WAIT(); asm volatile("" ::: "memory");
    const int c = lane & 7;
#pragma unroll
    for (int j = 0; j < 4; ++j) { const int n = (lane >> 3) + 8 * j; const LAS float* q = scr + (8 * c) * 33 + n;
        u32x4 o; o.x = pk2(q[0 * 33], q[1 * 33]); o.y = pk2(q[2 * 33], q[3 * 33]); o.z = pk2(q[4 * 33], q[5 * 33]); o.w = pk2(q[6 * 33], q[7 * 33]);
        *(GAS u32x4*)(t.dst + (size_t)(t.drow0 + n) * t.K + t.k0 + 8 * c) = o; }
    LDS_WAIT(); asm volatile("" ::: "memory");
}
__device__ __forceinline__ TItem ti_get(Frame& F, int stage, int r) {
    unsigned char* ws = F.ws; TItem t;
    constexpr int I_IN = (D / 64) * (2 * LW / 32), I_G = LH * (LB / 64) * (2 * LB / 32), I_SQ = (D / 64) * (D / 32), I_FU = (D / 64) * (FF / 32);
    if (stage == 0) {
        if (r < I_IN) { const int nb = 2 * LW / 32; t = TItem{ARG_IN(F, I_WIN), (bf16*)(ws + WS_WIN), 2 * LW, D, 64 * (r / nb), 32 * (r % nb), 32 * (r % nb)}; return t; } r -= I_IN;
        if (r < I_G) { const int h = r / 64, rr = r % 64, n0 = 32 * (rr % 16);
            t = TItem{ARG_IN(F, I_WGATES) + (size_t)h * LB * 2 * LB, (bf16*)(ws + WS_WG), 2 * LB, LB, 64 * (rr / 16), n0, (2 * h + ((n0 % 256) / 128)) * 256 + 128 * (n0 / 256) + (n0 % 128)}; return t; } r -= I_G;
        { const int nb = D / 32; t = TItem{ARG_IN(F, I_WOUT), (bf16*)(ws + WS_WOUT), D, LW, 64 * (r / nb), 32 * (r % nb), 32 * (r % nb)}; return t; }
    }
    const int l = stage - 1;
    if (stage == 2) {
        if (r < 3 * I_SQ) { const int w = r / I_SQ, rr = r % I_SQ, nb = D / 32;
            t = TItem{w == 0 ? ARG_IN(F, I_WKV) : (w == 1 ? ARG_IN(F, I_WQ) : ARG_IN(F, I_WO)), (bf16*)(ws + (w == 0 ? WS_WKV : (w == 1 ? WS_WQ : WS_WO))), D, D, 64 * (rr / nb), 32 * (rr % nb), 32 * (rr % nb)}; return t; } r -= 3 * I_SQ;
    }
    if (r < 2 * I_FU) { const int up = r / I_FU, rr = r % I_FU, nb = FF / 32, n0 = 32 * (rr % nb);
        t = TItem{(up ? ARG_IN(F, I_FUP) : ARG_IN(F, I_FGATE)) + (size_t)l * D * FF, (bf16*)(ws + (l ? WS_WGU1 : WS_WGU0)), FF, D, 64 * (rr / nb), n0, 256 * (n0 / 128) + 128 * up + (n0 % 128)}; return t; } r -= 2 * I_FU;
    { const int nb = D / 32; t = TItem{ARG_IN(F, I_FDOWN) + (size_t)l * FF * D, (bf16*)(ws + (l ? WS_WD1 : WS_WD0)), D, FF, 64 * (r / nb), 32 * (r % nb), 32 * (r % nb)}; return t; }
}
__device__ __forceinline__ void p_weights(Frame& F, int stage, int gw, int NGW) {
    LAS float* scr = (LAS float*)(F.lds + RING_OFF + 16384 + F.wave * 12288);
    constexpr int I_IN = (D / 64) * (2 * LW / 32), I_G = LH * (LB / 64) * (2 * LB / 32), I_OUT = (LW / 64) * (D / 32), I_SQ = (D / 64) * (D / 32), I_FU = (D / 64) * (FF / 32), I_FD = (FF / 64) * (D / 32);
    const int nitems = stage == 0 ? I_IN + I_G + I_OUT : (stage == 1 ? 2 * I_FU + I_FD : 3 * I_SQ + 2 * I_FU + I_FD);
    if (stage == 0)
        for (int i = F.bid * 512 + F.tid; i < LW; i += F.G * 512) { const float x = -ARG_IN(F, I_LAMBDA)[i]; const float sp = fmaxf(x, 0.f) + log1pf(__expf(-fabsf(x))); ((float*)(F.ws + WS_C8))[i] = 8.0f * sp; }
    int it = gw; if (it >= nitems) return;
    float va[32], vb[32];
    TItem ta = ti_get(F, stage, it), tb = ta; ti_load(ta, va, F.lane);
    for (;;) {
        const int it2 = it + NGW; const bool m2 = it2 < nitems;
        if (m2) { tb = ti_get(F, stage, it2); ti_load(tb, vb, F.lane); }
        ti_store(ta, va, scr, F.lane);
        if (!m2) break;
        const int it3 = it2 + NGW; const bool m3 = it3 < nitems;
        if (m3) { ta = ti_get(F, stage, it3); ti_load(ta, va, F.lane); }
        ti_store(tb, vb, scr, F.lane);
        if (!m3) break;
        it = it3;
    }
}
__device__ __forceinline__ void p_weights_bubble(Frame& F, int stage) {
    const int G = F.G, rounds = (640 + G - 1) / G, full = 640 - (rounds - 1) * G;
    if (F.dry) return;
    if (full < G) { if (F.bid >= full) p_weights(F, stage, (F.bid - full) * 8 + F.wave, (G - full) * 8); }
    else p_weights(F, stage, F.bid * 8 + F.wave, G * 8);
}
template <int NOUT, bool XBF>
__device__ __forceinline__ void norm_mod_rows(Frame& F, const void* X, const float* g0, const float* sh0, const float* sc0, int bs0, bf16* o0,
                                              const float* g1, const float* sh1, const float* sc1, int bs1, bf16* o1) {
    const int gw = F.bid * 8 + F.wave, NGW = F.G * 8;
    for (int b = 0; b < BATCH; ++b) {
        f32x4 gs0[4], sv0[4], gs1[4], sv1[4];
#pragma unroll
        for (int j = 0; j < 4; ++j) { const int c = 8 * (F.lane + 64 * (j >> 1)) + 4 * (j & 1);
            const f32x4 g = *(const f32x4*)(g0 + c), sc = *(const f32x4*)(sc0 + (size_t)b * bs0 + c); gs0[j] = g * (sc + 1.0f); sv0[j] = *(const f32x4*)(sh0 + (size_t)b * bs0 + c);
            if (NOUT == 2) { const f32x4 gB = *(const f32x4*)(g1 + c), scB = *(const f32x4*)(sc1 + (size_t)b * bs1 + c); gs1[j] = gB * (scB + 1.0f); sv1[j] = *(const f32x4*)(sh1 + (size_t)b * bs1 + c); } }
        u32x4 rawb[2]; f32x4 rawf[4];
        auto load_row = [&](int m) {
            if constexpr (XBF) { const u32x4* xr = (const u32x4*)((const bf16*)X + (size_t)m * D) + F.lane; rawb[0] = xr[0]; rawb[1] = xr[64]; }
            else { const f32x4* xr = (const f32x4*)((const float*)X + (size_t)m * D) + 2 * F.lane; rawf[0] = __builtin_nontemporal_load(xr); rawf[1] = __builtin_nontemporal_load(xr + 1); rawf[2] = __builtin_nontemporal_load(xr + 128); rawf[3] = __builtin_nontemporal_load(xr + 129); } };
        int m = b * SEQ + gw; const int mend = (b + 1) * SEQ;
        if (m < mend) load_row(m);
        for (; m < mend; m += NGW) {
            f32x4 v[4]; float s = 0.f;
            if constexpr (XBF) {
#pragma unroll
                for (int jj = 0; jj < 2; ++jj) { const u32x4 w = rawb[jj]; v[2 * jj] = (f32x4){bflo(w.x), bfhi(w.x), bflo(w.y), bfhi(w.y)}; v[2 * jj + 1] = (f32x4){bflo(w.z), bfhi(w.z), bflo(w.w), bfhi(w.w)}; }
            } else {
#pragma unroll
                for (int j = 0; j < 4; ++j) v[j] = rawf[j]; }
            if (m + NGW < mend) load_row(m + NGW);
#pragma unroll
            for (int j = 0; j < 4; ++j) s += (v[j].x * v[j].x + v[j].y * v[j].y) + (v[j].z * v[j].z + v[j].w * v[j].w);
            const float rstd = 1.0f / sqrtf(wave_sum(s) * (1.0f / D) + RMS_EPS);
            u32x4* p0 = (u32x4*)(o0 + (size_t)m * D) + F.lane;
#pragma unroll
            for (int jj = 0; jj < 2; ++jj) { const f32x4 y0 = v[2 * jj] * rstd * gs0[2 * jj] + sv0[2 * jj], y1 = v[2 * jj + 1] * rstd * gs0[2 * jj + 1] + sv0[2 * jj + 1];
                u32x4 w; w.x = pk2(y0.x, y0.y); w.y = pk2(y0.z, y0.w); w.z = pk2(y1.x, y1.y); w.w = pk2(y1.z, y1.w); p0[64 * jj] = w; }
            if (NOUT == 2) { u32x4* p1 = (u32x4*)(o1 + (size_t)m * D) + F.lane;
#pragma unroll
                for (int jj = 0; jj < 2; ++jj) { const f32x4 y0 = v[2 * jj] * rstd * gs1[2 * jj] + sv1[2 * jj], y1 = v[2 * jj + 1] * rstd * gs1[2 * jj + 1] + sv1[2 * jj + 1];
                    u32x4 w; w.x = pk2(y0.x, y0.y); w.y = pk2(y0.z, y0.w); w.z = pk2(y1.x, y1.y); w.w = pk2(y1.z, y1.w); p1[64 * jj] = w; } }
        }
    }
}
__device__ __forceinline__ void final_norm_rows(Frame& F, const float* X, float* O, const float* g) {
    const int gw = F.bid * 8 + F.wave, NGW = F.G * 8;
    f32x4 gg[4];
#pragma unroll
    for (int j = 0; j < 4; ++j) gg[j] = *(const f32x4*)(g + 4 * (F.lane + 64 * j));
    f32x4 nx[4];
    int m = gw;
    if (m < M) { const f32x4* xr = (const f32x4*)(X + (size_t)m * D) + F.lane;
#pragma unroll
        for (int j = 0; j < 4; ++j) nx[j] = xr[64 * j]; }
    for (; m < M; m += NGW) {
        f32x4 v[4]; float s = 0.f;
#pragma unroll
        for (int j = 0; j < 4; ++j) v[j] = nx[j];
        if (m + NGW < M) { const f32x4* xr = (const f32x4*)(X + (size_t)(m + NGW) * D) + F.lane;
#pragma unroll
            for (int j = 0; j < 4; ++j) nx[j] = xr[64 * j]; }
#pragma unroll
        for (int j = 0; j < 4; ++j) s += (v[j].x * v[j].x + v[j].y * v[j].y) + (v[j].z * v[j].z + v[j].w * v[j].w);
        const float rstd = 1.0f / sqrtf(wave_sum(s) * (1.0f / D) + RMS_EPS);
        f32x4* orow = (f32x4*)(O + (size_t)m * D) + F.lane;
#pragma unroll
        for (int j = 0; j < 4; ++j) __builtin_nontemporal_store(v[j] * rstd * gg[j], orow + 64 * j);
    }
}

__device__ __forceinline__ void p_conv(Frame& F) {
    const bf16* XB = (const bf16*)(F.ws + WS_XB); bf16* XC = (bf16*)(F.ws + WS_XC);
    const float* cw = ARG_IN(F, I_CONVW); const float* cb = ARG_IN(F, I_CONVB);
    const int NT = F.G * 512;
    for (int gid = F.bid * 512 + F.tid; gid < (M / 32) * (LW / 8); gid += NT) {
        const int cg = gid % (LW / 8), chunk = gid / (LW / 8), ch = cg * 8, m0 = chunk * 32;
        float w0[8], w1[8], w2[8], w3[8], bb[8];
#pragma unroll
        for (int e = 0; e < 8; ++e) { w0[e] = cw[ch + e]; w1[e] = cw[LW + ch + e]; w2[e] = cw[2 * LW + ch + e]; w3[e] = cw[3 * LW + ch + e]; bb[e] = cb[ch + e]; }
        float x3[8], x2[8], x1[8], x0[8];
        if ((m0 % SEQ) == 0) {
#pragma unroll
            for (int e = 0; e < 8; ++e) { x3[e] = 0.f; x2[e] = 0.f; x1[e] = 0.f; }
        } else {
            unpack8(*(const u32x4*)(XB + (size_t)(m0 - 3) * LW + ch), x3); unpack8(*(const u32x4*)(XB + (size_t)(m0 - 2) * LW + ch), x2); unpack8(*(const u32x4*)(XB + (size_t)(m0 - 1) * LW + ch), x1);
        }
#pragma unroll 4
        for (int r = 0; r < 32; ++r) {
            unpack8(*(const u32x4*)(XB + (size_t)(m0 + r) * LW + ch), x0);
            float o[8];
#pragma unroll
            for (int e = 0; e < 8; ++e) { o[e] = bb[e] + w0[e] * x3[e] + w1[e] * x2[e] + w2[e] * x1[e] + w3[e] * x0[e]; x3[e] = x2[e]; x2[e] = x1[e]; x1[e] = x0[e]; }
            u32x4 w; w.x = pk2(o[0], o[1]); w.y = pk2(o[2], o[3]); w.z = pk2(o[4], o[5]); w.w = pk2(o[6], o[7]);
            *(u32x4*)(XC + (size_t)(m0 + r) * LW + ch) = w;
        }
    }
}
__device__ __forceinline__ void fixup_conv_rows(Frame& F) {
    const bf16* RAWS = (const bf16*)(F.ws + WS_RAWS); bf16* XC = (bf16*)(F.ws + WS_XC);
    const float* cw = ARG_IN(F, I_CONVW); const float* cb = ARG_IN(F, I_CONVB);
    for (int L = F.bid; L < 640; L += F.G) {
        const int pm = L / 10, h = (L - 10 * pm) >> 1;
        if (F.tid < 192) {
            const int wr = F.tid / 96, j = (F.tid / 32) % 3, ch = 256 * h + 8 * (F.tid & 31);
            const int seg = pm * 2 + wr; const bool first = (pm % (SEQ / 256) == 0) && wr == 0;
            float xs[6][8];
#pragma unroll
            for (int k = 0; k < 3; ++k) {
                if (first) {
#pragma unroll
                    for (int e = 0; e < 8; ++e) xs[k][e] = 0.f;
                } else unpack8(*(const u32x4*)(RAWS + (size_t)((seg - 1) * 6 + 3 + k) * LW + ch), xs[k]);
                unpack8(*(const u32x4*)(RAWS + (size_t)(seg * 6 + k) * LW + ch), xs[3 + k]); }
            float o[8];
#pragma unroll
            for (int e = 0; e < 8; ++e) o[e] = cb[ch + e];
#pragma unroll
            for (int jj = 0; jj < 3; ++jj) if (jj == j) {
#pragma unroll
                for (int e = 0; e < 8; ++e) o[e] += cw[ch + e] * xs[jj][e] + cw[LW + ch + e] * xs[jj + 1][e] + cw[2 * LW + ch + e] * xs[jj + 2][e] + cw[3 * LW + ch + e] * xs[jj + 3][e]; }
            u32x4 w; w.x = pk2(o[0], o[1]); w.y = pk2(o[2], o[3]); w.z = pk2(o[4], o[5]); w.w = pk2(o[6], o[7]);
            *(u32x4*)(XC + (size_t)(pm * 256 + wr * 128 + j) * LW + ch) = w;
        }
    }
    asm volatile("s_waitcnt vmcnt(0)" ::: "memory");
    __syncthreads();
}
constexpr int SCH = 32, NCH = SEQ / SCH, CG = LW / 8;
__device__ __forceinline__ void p_scan1(Frame& F) {
    const u32x4* LA = (const u32x4*)(F.ws + WS_XB); const u32x4* BB = (const u32x4*)(F.ws + WS_BB);
    float* SA = (float*)(F.ws + WS_SA); float* SB = (float*)(F.ws + WS_SB);
    const int NT = F.G * 512;
    for (int gid = F.bid * 512 + F.tid; gid < BATCH * NCH * CG; gid += NT) {
        const int g = gid % CG, bc = gid / CG;
        const u32x4* la = LA + (size_t)bc * SCH * CG + g; const u32x4* bb = BB + (size_t)bc * SCH * CG + g;
        float h[8], sm[8];
#pragma unroll
        for (int e = 0; e < 8; ++e) { h[e] = 0.f; sm[e] = 0.f; }
#pragma unroll 1
        for (int r0 = 0; r0 < SCH; r0 += 16) {
            u32x4 lv[16], bv[16];
#pragma unroll
            for (int r = 0; r < 16; ++r) { lv[r] = la[(size_t)(r0 + r) * CG]; bv[r] = bb[(size_t)(r0 + r) * CG]; }
#pragma unroll
            for (int r = 0; r < 16; ++r) { float l[8], u[8]; unpack8(lv[r], l); unpack8(bv[r], u);
#pragma unroll
                for (int e = 0; e < 8; ++e) { h[e] = fexp2(l[e] * LOG2E) * h[e] + u[e]; sm[e] += l[e]; } }
        }
        f32x4* sa = (f32x4*)(SA + (size_t)bc * LW + 8 * g); f32x4* sb = (f32x4*)(SB + (size_t)bc * LW + 8 * g);
        sa[0] = (f32x4){fexp2(sm[0] * LOG2E), fexp2(sm[1] * LOG2E), fexp2(sm[2] * LOG2E), fexp2(sm[3] * LOG2E)};
        sa[1] = (f32x4){fexp2(sm[4] * LOG2E), fexp2(sm[5] * LOG2E), fexp2(sm[6] * LOG2E), fexp2(sm[7] * LOG2E)};
        sb[0] = (f32x4){h[0], h[1], h[2], h[3]}; sb[1] = (f32x4){h[4], h[5], h[6], h[7]};
    }
}
__device__ __forceinline__ void p_scan_carry(Frame& F) {
    const float* SA = (const float*)(F.ws + WS_SA); float* SB = (float*)(F.ws + WS_SB);
    LAS float* segA = (LAS float*)(F.lds + RING_OFF); LAS float* segB = segA + 512;
    const int seg = F.tid >> 5, cl = F.tid & 31;
    for (int it = F.bid; it < BATCH * (LW / 32); it += F.G) {
        const int b = it / (LW / 32), ch = (it % (LW / 32)) * 32 + cl;
        const size_t base = (size_t)(b * NCH + 16 * seg) * LW + ch;
        float a[16], bq[16];
#pragma unroll
        for (int j = 0; j < 16; ++j) { a[j] = SA[base + (size_t)j * LW]; bq[j] = SB[base + (size_t)j * LW]; }
        float A = 1.f, B = 0.f;
#pragma unroll
        for (int j = 0; j < 16; ++j) { B = a[j] * B + bq[j]; A *= a[j]; }
        segA[seg * 32 + cl] = A; segB[seg * 32 + cl] = B;
        __syncthreads();
        float H = 0.f;
        for (int s2 = 0; s2 < seg; ++s2) H = segA[s2 * 32 + cl] * H + segB[s2 * 32 + cl];
#pragma unroll
        for (int j = 0; j < 16; ++j) { SB[base + (size_t)j * LW] = H; H = a[j] * H + bq[j]; }
        __syncthreads();
    }
}
__device__ __forceinline__ void p_scan2(Frame& F) {
    const u32x4* LA = (const u32x4*)(F.ws + WS_XB); const u32x4* BB = (const u32x4*)(F.ws + WS_BB);
    u32x4* Y = (u32x4*)(F.ws + WS_Y); u32x4* YO = F.dry ? (u32x4*)(F.ws + WS_XC) : Y;
    const float* SB = (const float*)(F.ws + WS_SB);
    const int NT = F.G * 512;
    for (int gid = F.bid * 512 + F.tid; gid < BATCH * NCH * CG; gid += NT) {
        const int g = gid % CG, bc = gid / CG;
        const size_t base = (size_t)bc * SCH * CG + g;
        float h[8];
        { const f32x4 c0 = *(const f32x4*)(SB + (size_t)bc * LW + 8 * g), c1 = *(const f32x4*)(SB + (size_t)bc * LW + 8 * g + 4);
          h[0] = c0.x; h[1] = c0.y; h[2] = c0.z; h[3] = c0.w; h[4] = c1.x; h[5] = c1.y; h[6] = c1.z; h[7] = c1.w; }
#pragma unroll 1
        for (int r0 = 0; r0 < SCH; r0 += 8) {
            u32x4 lv[8], bv[8], yv[8];
#pragma unroll
            for (int r = 0; r < 8; ++r) { const size_t o = base + (size_t)(r0 + r) * CG; lv[r] = LA[o]; bv[r] = BB[o]; yv[r] = Y[o]; }
#pragma unroll
            for (int r = 0; r < 8; ++r) { float l[8], u[8], y[8]; unpack8(lv[r], l); unpack8(bv[r], u); unpack8(yv[r], y);
#pragma unroll
                for (int e = 0; e < 8; ++e) h[e] = fexp2(l[e] * LOG2E) * h[e] + u[e];
                u32x4 w; w.x = pk2(h[0] * y[0], h[1] * y[1]); w.y = pk2(h[2] * y[2], h[3] * y[3]); w.z = pk2(h[4] * y[4], h[5] * y[5]); w.w = pk2(h[6] * y[6], h[7] * y[7]);
                YO[base + (size_t)(r0 + r) * CG] = w; }
        }
    }
}

__device__ __forceinline__ void p_kmean(Frame& F) {
    if (F.dry && DRY_VARIANT == 5) return;
    const bf16* KB = (const bf16*)((unsigned char*)F.out + DO_KB); float* KM = (float*)(F.ws + WS_KM);
    LAS float* red = (LAS float*)(F.lds + RING_OFF);
    const int dg = F.lane & 15, rg = F.wave * 4 + (F.lane >> 4);
    for (int it = F.bid; it < BATCH * NKV * NB; it += F.G) {
        const int n = it % NB, kvh = (it / NB) % NKV, b = it / (NB * NKV);
        const u32x4* kp = (const u32x4*)(KB + (size_t)(b * SEQ + n * BLK + rg * 8) * (NKV * HD) + kvh * HD) + dg;
        float sm[8];
#pragma unroll
        for (int e = 0; e < 8; ++e) sm[e] = 0.f;
        u32x4 kv[8];
#pragma unroll
        for (int r = 0; r < 8; ++r) kv[r] = kp[(size_t)r * (NKV * HD / 8)];
#pragma unroll
        for (int r = 0; r < 8; ++r) { float x[8]; unpack8(kv[r], x);
#pragma unroll
            for (int e = 0; e < 8; ++e) sm[e] += x[e]; }
#pragma unroll
        for (int e = 0; e < 8; ++e) red[rg * 128 + 8 * dg + e] = sm[e];
        __syncthreads();
        if (F.tid < 128) { float t = 0.f;
#pragma unroll
            for (int w = 0; w < 32; ++w) t += red[w * 128 + F.tid];
            KM[(size_t)it * HD + F.tid] = t * (1.0f / BLK); }
        __syncthreads();
    }
}
#define MFMA32(a, b, c) __builtin_amdgcn_mfma_f32_32x32x16_bf16((a), (b), (c), 0, 0, 0)
__device__ __forceinline__ void top3_insert(float g, int n, float& v0, float& v1, float& v2, int& i0, int& i1, int& i2) {
    const bool c0 = g > v0, c1 = g > v1, c2 = g > v2;
    const float nv2 = c1 ? v1 : (c2 ? g : v2); const int ni2 = c1 ? i1 : (c2 ? n : i2);
    const float nv1 = c0 ? v0 : (c1 ? g : v1); const int ni1 = c0 ? i0 : (c1 ? n : i1);
    v0 = c0 ? g : v0; i0 = c0 ? n : i0; v1 = nv1; i1 = ni1; v2 = nv2; i2 = ni2;
}
__device__ __forceinline__ void gate_group(const bf16x8 (&qf)[8], const bf16x8 (&kh)[8], const bf16x8 (&kl)[8], LAS int* cntl, int kvh, int hi, int own,
                                           int& s0, int& s1, int& s2, int& p0, int& p1, int& p2) {
    f32x16 acc;
#pragma unroll
    for (int r = 0; r < 16; ++r) acc[r] = 0.f;
#pragma unroll
    for (int ks = 0; ks < 8; ++ks) { acc = MFMA32(kh[ks], qf[ks], acc); acc = MFMA32(kl[ks], qf[ks], acc); }
    int i0 = -1, i1 = -1, i2 = -1; float v0 = -3.0e38f, v1 = -3.0e38f, v2 = -3.0e38f;
#pragma unroll
    for (int r = 0; r < 16; ++r) { const int n = (r & 3) + 8 * (r >> 2) + 4 * hi; top3_insert(n < own ? acc[r] : -3.0e38f, n, v0, v1, v2, i0, i1, i2); }
    const float w0 = __shfl_xor(v0, 32), w1 = __shfl_xor(v1, 32), w2 = __shfl_xor(v2, 32);
    const int j0 = __shfl_xor(i0, 32), j1 = __shfl_xor(i1, 32), j2 = __shfl_xor(i2, 32);
    top3_insert(j0 >= 0 ? w0 : -3.0e38f, j0, v0, v1, v2, i0, i1, i2);
    top3_insert(j1 >= 0 ? w1 : -3.0e38f, j1, v0, v1, v2, i0, i1, i2);
    top3_insert(j2 >= 0 ? w2 : -3.0e38f, j2, v0, v1, v2, i0, i1, i2);
    s0 = i0; s1 = i1; s2 = i2; p0 = 0; p1 = 0; p2 = 0;
    if (hi == 0) {
        if (i0 >= 0) p0 = __hip_atomic_fetch_add(&cntl[kvh * NB + i0], 1, __ATOMIC_RELAXED, __HIP_MEMORY_SCOPE_WORKGROUP);
        if (i1 >= 0) p1 = __hip_atomic_fetch_add(&cntl[kvh * NB + i1], 1, __ATOMIC_RELAXED, __HIP_MEMORY_SCOPE_WORKGROUP);
        if (i2 >= 0) p2 = __hip_atomic_fetch_add(&cntl[kvh * NB + i2], 1, __ATOMIC_RELAXED, __HIP_MEMORY_SCOPE_WORKGROUP);
    }
}
__device__ __forceinline__ void p_gate(Frame& F) {
    const bf16* QB = (const bf16*)((unsigned char*)F.out + DO_QB); const float* KM = (const float*)(F.ws + WS_KMP);
    unsigned* LIST = (unsigned*)(F.ws + (F.dry ? WS_OP : WS_LIST)); unsigned* gcnt = (unsigned*)(F.ws + WS_CTL) + CW_LCNT + (F.dry ? 256 : 0);
    LAS int* cntl = (LAS int*)(F.lds + RING_OFF);
    const int h = F.wave, kvh = h >> 1, li = F.lane & 31, hi = F.lane >> 5;
    for (int tile = F.bid; tile < M / 64; tile += F.G) {
        const int b = tile / (SEQ / 64), t0 = (tile % (SEQ / 64)) * 64, own = t0 / BLK;
        if (F.tid < 256) cntl[F.tid] = 0;
        __syncthreads();
        const bf16* qpa = QB + (size_t)(b * SEQ + t0 + li) * D + h * HD + 8 * hi;
        bf16x8 qa[8], qb[8];
#pragma unroll
        for (int ks = 0; ks < 8; ++ks) qa[ks] = *(const bf16x8*)(qpa + 16 * ks);
#pragma unroll
        for (int ks = 0; ks < 8; ++ks) qb[ks] = *(const bf16x8*)(qpa + (size_t)32 * D + 16 * ks);
        bf16x8 kh[8], kl[8];
        { const float* kmp = KM + ((size_t)(b * NB + li)) * (NKV * HD) + kvh * HD + 8 * hi; const float* kmq = kmp + (size_t)(M / 256) * (NKV * HD);
#pragma unroll
          for (int kq = 0; kq < 2; ++kq) {
              f32x4 pa[4], pb[4], pc[4], pd[4];
#pragma unroll
              for (int k = 0; k < 4; ++k) { const int ks = 4 * kq + k; pa[k] = *(const f32x4*)(kmp + 16 * ks); pb[k] = *(const f32x4*)(kmq + 16 * ks); pc[k] = *(const f32x4*)(kmp + 16 * ks + 4); pd[k] = *(const f32x4*)(kmq + 16 * ks + 4); }
#pragma unroll
              for (int k = 0; k < 4; ++k) { const int ks = 4 * kq + k; const f32x4 a = pa[k] + pb[k], c = pc[k] + pd[k];
                  u32x4 wh; wh.x = pk2(a.x, a.y); wh.y = pk2(a.z, a.w); wh.z = pk2(c.x, c.y); wh.w = pk2(c.z, c.w);
                  u32x4 wl; wl.x = pk2(a.x - bflo(wh.x), a.y - bfhi(wh.x)); wl.y = pk2(a.z - bflo(wh.y), a.w - bfhi(wh.y)); wl.z = pk2(c.x - bflo(wh.z), c.y - bfhi(wh.z)); wl.w = pk2(c.z - bflo(wh.w), c.w - bfhi(wh.w));
                  kh[ks] = __builtin_bit_cast(bf16x8, wh); kl[ks] = __builtin_bit_cast(bf16x8, wl); } } }
        int sa0, sa1, sa2, pa0, pa1, pa2, sb0, sb1, sb2, pb0, pb1, pb2;
        gate_group(qa, kh, kl, cntl, kvh, hi, own, sa0, sa1, sa2, pa0, pa1, pa2);
        gate_group(qb, kh, kl, cntl, kvh, hi, own, sb0, sb1, sb2, pb0, pb1, pb2);
        __syncthreads();
        if (F.tid < 128) { const int c = cntl[F.tid]; int base = 0; if (c > 0) base = (int)atomicAdd(&gcnt[b * 128 + F.tid], (unsigned)c); cntl[128 + F.tid] = base; }
        __syncthreads();
        if (hi == 0) {
            const size_t lb = (size_t)(b * 128 + kvh * NB); const int cb = 128 + kvh * NB;
            const unsigned ea = ((unsigned)(t0 + li) << 3) | ((unsigned)(h & 1) << 2), eb = ((unsigned)(t0 + 32 + li) << 3) | ((unsigned)(h & 1) << 2);
            if (sa0 >= 0) LIST[(lb + sa0) * LIST_CAP + cntl[cb + sa0] + pa0] = ea | 0u;
            if (sa1 >= 0) LIST[(lb + sa1) * LIST_CAP + cntl[cb + sa1] + pa1] = ea | 1u;
            if (sa2 >= 0) LIST[(lb + sa2) * LIST_CAP + cntl[cb + sa2] + pa2] = ea | 2u;
            if (sb0 >= 0) LIST[(lb + sb0) * LIST_CAP + cntl[cb + sb0] + pb0] = eb | 0u;
            if (sb1 >= 0) LIST[(lb + sb1) * LIST_CAP + cntl[cb + sb1] + pb1] = eb | 1u;
            if (sb2 >= 0) LIST[(lb + sb2) * LIST_CAP + cntl[cb + sb2] + pb2] = eb | 2u;
        }
        __syncthreads();
    }
}

constexpr int HBUF = 65536;
__device__ __forceinline__ void build_bias_table(Frame& F) {
    LAS float* BT = (LAS float*)(F.lds + BT_OFF);
    for (int i = F.tid; i < NH * 128; i += 512) { const int h = i >> 7, d = i & 127; int bk;
        if (d < 16) bk = d; else { bk = 16 + (int)(logf((float)d / 16.0f) / 2.0794415416798357f * 16.0f); bk = bk < 31 ? bk : 31; }
        BT[i] = ARG_IN(F, I_RELB)[h * 32 + bk] * LOG2E; }
}
__device__ __forceinline__ void glds_half(Frame& F, int b, int kvh, int n, int half, int buf) {
    int ln = F.lane; asm volatile("" : "+v"(ln));
    const int wv = F.wave;
    const char* kb = (const char*)((const bf16*)((unsigned char*)F.out + DO_KB) + (size_t)(b * SEQ + n * BLK + half * 128 + 16 * wv) * (NKV * HD) + kvh * HD);
    const char* vb = (const char*)((const bf16*)((unsigned char*)F.out + DO_VT) + (size_t)(kvh * HD + 16 * wv) * M + b * SEQ + n * BLK + half * 128);
    const int r4 = ln >> 4, slot = ln & 15;
#pragma unroll
    for (int i = 0; i < 4; ++i) { const int rr = 4 * i + r4; const unsigned ko = (unsigned)(rr * (NKV * HD) * 2 + ((slot ^ rr) << 4));
        __builtin_amdgcn_global_load_lds((const unsigned*)(kb + ko), (LAS unsigned*)(F.lds + RING_OFF + buf * HBUF + (wv * 4 + i) * 1024), 16, 0, 0); }
#pragma unroll
    for (int i = 0; i < 4; ++i) { const int rr = 4 * i + r4; const unsigned vo = (unsigned)rr * (unsigned)(M * 2) + (unsigned)((slot ^ rr) << 4);
        __builtin_amdgcn_global_load_lds((const unsigned*)(vb + vo), (LAS unsigned*)(F.lds + RING_OFF + buf * HBUF + 32768 + (wv * 4 + i) * 1024), 16, 0, 0); }
}
#define ATT_WAIT_BAR() do { asm volatile("s_waitcnt vmcnt(0) lgkmcnt(0)" ::: "memory"); __builtin_amdgcn_s_barrier(); asm volatile("" ::: "memory"); } while (0)
struct AttState { f32x16 o[4]; float m, l; };
template <int MODE>
__device__ __forceinline__ void attn_tile(Frame& F, AttState& st, const bf16x8 (&qf)[8], const int kbase, const int vbase, int kt, int qpos, int hbase, float cb) {
    const int hi = F.lane >> 5;
    const LAS float* BT = (const LAS float*)(F.lds + BT_OFF) + hbase;
    const LAS unsigned char* hb = F.lds + RING_OFF + (kt >> 1) * HBUF;
    const int kl = kt & 1;
    f32x16 s[2];
#pragma unroll
    for (int sub = 0; sub < 2; ++sub) {
        f32x16 a;
#pragma unroll
        for (int r = 0; r < 16; ++r) a[r] = 0.f;
#pragma unroll
        for (int ks = 0; ks < 8; ++ks) { const bf16x8 kf = *(const LAS bf16x8*)(hb + (kbase ^ (ks << 5)) + (64 * kl + 32 * sub) * 256); a = MFMA32(kf, qf[ks], a); }
        s[sub] = a;
    }
    float mx = -1.0e30f;
#pragma unroll
    for (int sub = 0; sub < 2; ++sub) {
        if (MODE == 0) {
#pragma unroll
            for (int r = 0; r < 16; ++r) { const float v = s[sub][r] + cb; s[sub][r] = v; mx = fmaxf(mx, v); }
        } else {
            float bt[16];
#pragma unroll
            for (int r = 0; r < 16; ++r) { const int dist = qpos - (64 * kt + 32 * sub + (r & 7) + 8 * hi + 16 * (r >> 3)); const int idx = dist < 0 ? 0 : (dist > 127 ? 127 : dist); bt[r] = BT[idx]; }
            asm volatile("s_waitcnt lgkmcnt(0)" ::: "memory");
#pragma unroll
            for (int r = 0; r < 16; ++r) { const int dist = qpos - (64 * kt + 32 * sub + (r & 7) + 8 * hi + 16 * (r >> 3));
                float v = s[sub][r] + bt[r]; if (MODE == 2 && dist < 0) v = -1.0e30f;
                s[sub][r] = v; mx = fmaxf(mx, v); }
        }
    }
    mx = fmaxf(mx, __shfl_xor(mx, 32));
    if (__any(mx > st.m + 8.0f)) {
        const float mnew = fmaxf(st.m, mx), alpha = fexp2(st.m - mnew);
        st.m = mnew; st.l *= alpha;
#pragma unroll
        for (int db = 0; db < 4; ++db) st.o[db] = st.o[db] * alpha;
    }
    const float mcur = st.m;
    float ls = 0.f;
#pragma unroll
    for (int sub = 0; sub < 2; ++sub) {
        bf16x8 pf[2];
#pragma unroll
        for (int sh = 0; sh < 2; ++sh) { float p[8];
#pragma unroll
            for (int j = 0; j < 8; ++j) { p[j] = fexp2(s[sub][8 * sh + j] - mcur); ls += p[j]; }
            u32x4 w; w.x = pk2(p[0], p[1]); w.y = pk2(p[2], p[3]); w.z = pk2(p[4], p[5]); w.w = pk2(p[6], p[7]);
            pf[sh] = __builtin_bit_cast(bf16x8, w); }
#pragma unroll
        for (int db = 0; db < 4; ++db)
#pragma unroll
            for (int sh = 0; sh < 2; ++sh) { const bf16x8 vf = *(const LAS bf16x8*)(hb + 32768 + (vbase ^ ((kl * 4 + sub * 2 + sh) << 5)) + db * 32 * 256);
                st.o[db] = MFMA32(vf, pf[sh], st.o[db]); }
    }
    st.l += ls;
}
#define ATT_SGB(mask, n) __builtin_amdgcn_sched_group_barrier(mask, n, 0)
__device__ __forceinline__ void att_qk(Frame& F, f32x16& s, const bf16x8 (&qf)[8], const int kbase, const int j) {
    const LAS unsigned char* hb = F.lds + RING_OFF + (j >> 2) * HBUF + (j & 3) * (32 * 256);
    int kb = kbase; asm volatile("" : "+v"(kb));
    f32x16 a;
#pragma unroll
    for (int r = 0; r < 16; ++r) a[r] = 0.f;
#define ATT_KF(ks_) (*(const LAS bf16x8*)(hb + (kb ^ ((ks_) << 5))))
    bf16x8 f0 = ATT_KF(0), f1 = ATT_KF(1), f2;
    f2 = ATT_KF(2); a = MFMA32(f0, qf[0], a);
    f0 = ATT_KF(3); a = MFMA32(f1, qf[1], a);
    f1 = ATT_KF(4); a = MFMA32(f2, qf[2], a);
    f2 = ATT_KF(5); a = MFMA32(f0, qf[3], a);
    f0 = ATT_KF(6); a = MFMA32(f1, qf[4], a);
    f1 = ATT_KF(7); a = MFMA32(f2, qf[5], a);
    a = MFMA32(f0, qf[6], a);
    a = MFMA32(f1, qf[7], a);
#undef ATT_KF
    s = a;
}
template <int MODE>
__device__ __forceinline__ float att_bias_max(Frame& F, f32x16& s, const int j, int qh, int hbase, float cb) {
    const LAS float* BT = (const LAS float*)(F.lds + BT_OFF) + hbase;
    float mx = -1.0e30f;
    if (MODE != 0) {
        float bt[16];
#pragma unroll
        for (int r = 0; r < 16; ++r) { const int dist = qh - (32 * j + (r & 7) + 16 * (r >> 3)); const int idx = dist < 0 ? 0 : (dist > 127 ? 127 : dist); bt[r] = BT[idx]; }
        asm volatile("s_waitcnt lgkmcnt(0)" ::: "memory");
#pragma unroll
        for (int r = 0; r < 16; ++r) { const float v = s[r] + bt[r]; s[r] = v; mx = fmaxf(mx, v); }
    } else {
#pragma unroll
        for (int r = 0; r < 16; ++r) mx = fmaxf(mx, s[r]);
    }
    if (MODE == 0) mx += cb;
    return fmaxf(mx, __shfl_xor(mx, 32));
}
__device__ __forceinline__ void att_rescale(AttState& st, float mx) {
    if (__any(mx > st.m + 8.0f)) {
        const float mnew = fmaxf(st.m, mx), alpha = fexp2(st.m - mnew);
        st.m = mnew; st.l *= alpha;
#pragma unroll
        for (int db = 0; db < 4; ++db) st.o[db] = st.o[db] * alpha;
    }
}
__device__ __forceinline__ float att_finish(const f32x16& s, float mref, bf16x8 (&pf)[2]) {
    float ls = 0.f;
#pragma unroll
    for (int sh = 0; sh < 2; ++sh) { float p[8];
#pragma unroll
        for (int e = 0; e < 8; ++e) { p[e] = fexp2(s[8 * sh + e] - mref); ls += p[e]; }
        u32x4 w; w.x = pk2(p[0], p[1]); w.y = pk2(p[2], p[3]); w.z = pk2(p[4], p[5]); w.w = pk2(p[6], p[7]);
        pf[sh] = __builtin_bit_cast(bf16x8, w); }
    return ls;
}
__device__ __forceinline__ void att_pv(Frame& F, f32x16 (&o)[4], const bf16x8 (&pf)[2], const int vbase, const int j) {
    const LAS unsigned char* hb = F.lds + RING_OFF + (j >> 2) * HBUF + 32768;
    int vb = vbase; asm volatile("" : "+v"(vb));
    const int v0 = vb ^ (((j & 3) * 2 + 0) << 5), v1 = vb ^ (((j & 3) * 2 + 1) << 5);
#define ATT_VF(i_) (*(const LAS bf16x8*)(hb + (((i_) & 1) ? v1 : v0) + ((i_) >> 1) * 32 * 256))
    bf16x8 f0 = ATT_VF(0), f1 = ATT_VF(1), f2;
    f2 = ATT_VF(2); o[0] = MFMA32(f0, pf[0], o[0]);
    f0 = ATT_VF(3); o[0] = MFMA32(f1, pf[1], o[0]);
    f1 = ATT_VF(4); o[1] = MFMA32(f2, pf[0], o[1]);
    f2 = ATT_VF(5); o[1] = MFMA32(f0, pf[1], o[1]);
    f0 = ATT_VF(6); o[2] = MFMA32(f1, pf[0], o[2]);
    f1 = ATT_VF(7); o[2] = MFMA32(f2, pf[1], o[2]);
    o[3] = MFMA32(f0, pf[0], o[3]);
    o[3] = MFMA32(f1, pf[1], o[3]);
#undef ATT_VF
}
#define ATT_IL(nd, nv) do { _Pragma("unroll") for (int i_ = 0; i_ < 8; ++i_) { ATT_SGB(0x008, 1); ATT_SGB(0x100, nd); ATT_SGB(0x002, nv); } } while (0)
__device__ __forceinline__ void attn_lane_offsets(int lane, int& kbase, int& vbase) {
    const int i = lane & 31, hi = lane >> 5;
    const int pi = (i & ~12) | ((i & 8) >> 1) | ((i & 4) << 1);
    kbase = pi * 256 + (((hi ^ pi) & 15) << 4);
    vbase = i * 256 + (((hi ^ i) & 15) << 4);
}
__device__ __forceinline__ void attn_init(AttState& st) {
#pragma unroll
    for (int db = 0; db < 4; ++db)
#pragma unroll
        for (int r = 0; r < 16; ++r) st.o[db][r] = 0.f;
    st.m = -1.0e30f; st.l = 0.f;
}
__device__ __forceinline__ void store_row16(const f32x16 (&o)[4], float scale, bf16* rowp, int hi) {
#pragma unroll
    for (int db = 0; db < 4; ++db)
#pragma unroll
        for (int g = 0; g < 4; g += 2) {
            unsigned a0 = pk2(o[db][4 * g] * scale, o[db][4 * g + 1] * scale), a1 = pk2(o[db][4 * g + 2] * scale, o[db][4 * g + 3] * scale);
            unsigned b0 = pk2(o[db][4 * g + 4] * scale, o[db][4 * g + 5] * scale), b1 = pk2(o[db][4 * g + 6] * scale, o[db][4 * g + 7] * scale);
            const auto r0 = __builtin_amdgcn_permlane32_swap(a0, b0, false, false); const auto r1 = __builtin_amdgcn_permlane32_swap(a1, b1, false, false);
            u32x4 w; w.x = r0[0]; w.y = r1[0]; w.z = r0[1]; w.w = r1[1];
            *(u32x4*)(rowp + 32 * db + 8 * (g + hi)) = w; }
}
__device__ __forceinline__ void addrow16(f32x16 (&o)[4], float cs, const bf16* rowp, int hi) {
#pragma unroll
    for (int db = 0; db < 4; ++db)
#pragma unroll
        for (int g = 0; g < 4; g += 2) {
            const u32x4 w = *(const u32x4*)(rowp + 32 * db + 8 * (g + hi));
            const auto r0 = __builtin_amdgcn_permlane32_swap(w.x, w.z, false, false); const auto r1 = __builtin_amdgcn_permlane32_swap(w.y, w.w, false, false);
            o[db][4 * g] += cs * bflo(r0[0]); o[db][4 * g + 1] += cs * bfhi(r0[0]); o[db][4 * g + 2] += cs * bflo(r1[0]); o[db][4 * g + 3] += cs * bfhi(r1[0]);
            o[db][4 * g + 4] += cs * bflo(r0[1]); o[db][4 * g + 5] += cs * bfhi(r0[1]); o[db][4 * g + 6] += cs * bflo(r1[1]); o[db][4 * g + 7] += cs * bfhi(r1[1]); }
}
__device__ __forceinline__ unsigned pk4_fp8(float a, float b, float c, float d) { unsigned w = 0; w = __builtin_amdgcn_cvt_pk_fp8_f32(a, b, w, false); w = __builtin_amdgcn_cvt_pk_fp8_f32(c, d, w, true); return w; }
__device__ __forceinline__ void store_row_fp8(const f32x16 (&o)[4], float scale, unsigned char* base, unsigned off) {
#pragma unroll
    for (int db = 0; db < 4; ++db) {
        unsigned W[4];
#pragma unroll
        for (int g = 0; g < 4; ++g) W[g] = pk4_fp8(o[db][4 * g] * scale, o[db][4 * g + 1] * scale, o[db][4 * g + 2] * scale, o[db][4 * g + 3] * scale);
        const auto r0 = __builtin_amdgcn_permlane32_swap(W[0], W[2], false, false);
        const auto r1 = __builtin_amdgcn_permlane32_swap(W[1], W[3], false, false);
        u32x4 w; w.x = r0[0]; w.y = r0[1]; w.z = r1[0]; w.w = r1[1];
        *(u32x4*)(base + (off + 32u * db)) = w; }
}
__device__ __forceinline__ void addrow_fp8(f32x16 (&o)[4], float cs, const unsigned char* rowp, int hi) {
#pragma unroll
    for (int db = 0; db < 4; ++db) {
        const u32x4 x = *(const u32x4*)(rowp + 32 * db + 16 * hi);
        const auto r0 = __builtin_amdgcn_permlane32_swap(x.x, x.y, false, false);
        const auto r1 = __builtin_amdgcn_permlane32_swap(x.z, x.w, false, false);
        const unsigned G[4] = {r0[0], r1[0], r0[1], r1[1]};
#pragma unroll
        for (int g = 0; g < 4; ++g) { o[db][4 * g] += cs * __builtin_amdgcn_cvt_f32_fp8(G[g], 0); o[db][4 * g + 1] += cs * __builtin_amdgcn_cvt_f32_fp8(G[g], 1);
            o[db][4 * g + 2] += cs * __builtin_amdgcn_cvt_f32_fp8(G[g], 2); o[db][4 * g + 3] += cs * __builtin_amdgcn_cvt_f32_fp8(G[g], 3); } }
}
__device__ __forceinline__ int find_list(const LAS int* pre, int item) {
    int lo = 0, hi = 256;
#pragma unroll
    for (int it = 0; it < 8; ++it) { const int mid = (lo + hi) >> 1; if (pre[mid] <= item) lo = mid; else hi = mid; }
    return __builtin_amdgcn_readfirstlane(lo);
}

__device__ __forceinline__ void p_attn_sparse(Frame& F) {
    const bf16* QB = (const bf16*)((unsigned char*)F.out + DO_QB); const unsigned* LIST = (const unsigned*)(F.ws + WS_LIST);
    unsigned* gcnt = (unsigned*)(F.ws + WS_CTL) + CW_LCNT;
    bf16* OP = (bf16*)(F.ws + WS_OP); f32x2* ML = (f32x2*)(F.ws + WS_ML);
    LAS int* pre = (LAS int*)(F.lds + PRE_OFF);
    LAS int* cnts = pre + 264;
    build_bias_table(F);
    int pv = 0;
    if (F.tid < 256) { const int c = (int)__hip_atomic_load(gcnt + F.tid, RLX_AGENT); cnts[F.tid] = c; pv = (c + 255) >> 8; }
#pragma unroll
    for (int d = 1; d < 64; d <<= 1) { const int t = __shfl_up(pv, d); if (F.lane >= d) pv += t; }
    LAS int* wtot = pre + 528;
    if (F.lane == 63 && F.wave < 4) wtot[F.wave] = pv;
    __syncthreads();
    if (F.tid < 256) { int off = 0;
#pragma unroll
        for (int w = 0; w < 3; ++w) if (w < F.wave) off += wtot[w];
        pre[F.tid + 1] = pv + off; }
    if (F.tid == 0) pre[0] = 0;
    __syncthreads();
    const int total = (F.dry && DRY_VARIANT == 3) ? 0 : pre[256];
    int kbase, vbase; attn_lane_offsets(F.lane, kbase, vbase);
    const int hi = F.lane >> 5;
    int item = (F.G % pg8::NXCD) == 0 ? (F.bid % pg8::NXCD) * (F.G / pg8::NXCD) + F.bid / pg8::NXCD : F.bid;
    LAS int* litem = pre + 536;
    if (F.tid < 16) { const int ik = item + F.tid * F.G; int lo = 0, hi2 = 256;
#pragma unroll
        for (int it = 0; it < 8; ++it) { const int mid = (lo + hi2) >> 1; if (pre[mid] <= ik) lo = mid; else hi2 = mid; }
        litem[F.tid] = ik < total ? lo : 0; }
    __syncthreads();
    int kround = 0;
    int l = 0;
    unsigned ent = 0; bf16x8 qf[8]; bool valid = false;
#define SPARSE_FETCH_ENT(l_, item_) do { const int chunk_ = (item_) - pre[l_]; const int cnt_ = cnts[l_]; const int ri_ = chunk_ * 256 + F.wave * 32 + (F.lane & 31); \
        ent = LIST[(size_t)(l_) * LIST_CAP + (ri_ < cnt_ ? ri_ : cnt_ - 1)]; } while (0)
#define SPARSE_FETCH_Q(l_) do { const int t_ = (int)(ent >> 3), h_ = 2 * (((l_) >> 5) & 3) + (int)((ent >> 2) & 1u); const unsigned mrow_ = (unsigned)(((l_) >> 7) * SEQ + t_); \
        _Pragma("unroll") for (int ks = 0; ks < 8; ++ks) qf[ks] = *(const bf16x8*)(QB + (mrow_ * D + h_ * HD + 16 * ks + 8 * hi)); } while (0)
    if (item < total) { l = __builtin_amdgcn_readfirstlane(litem[0]); glds_half(F, l >> 7, (l >> 5) & 3, l & 31, 0, 0); SPARSE_FETCH_ENT(l, item); SPARSE_FETCH_Q(l); ATT_WAIT_BAR(); }
    while (item < total) {
        const int b = l >> 7, kvh = (l >> 5) & 3, n = l & 31;
        const int t = (int)(ent >> 3), h = 2 * kvh + (int)((ent >> 2) & 1u), slot = (int)(ent & 3u);
        const unsigned mrow = (unsigned)(b * SEQ + t);
        glds_half(F, b, kvh, n, 1, 1);
        const int item2 = item + F.G; int l2 = 0; const bool more = item2 < total;
        if (more) { l2 = __builtin_amdgcn_readfirstlane(litem[(kround + 1) & 15]); SPARSE_FETCH_ENT(l2, item2); }
        AttState st; attn_init(st);
        const int qpos = t - n * BLK;
        const LAS float* BT = (const LAS float*)(F.lds + BT_OFF);
        const float cb = BT[h * 128 + 127];
        const bool far = __all(qpos - 255 >= 127);
        int hiq = F.lane >> 5; asm volatile("" : "+v"(hiq)); const int qh = qpos - 8 * hiq;
#define SPARSE_IL_A(MODE) do { if ((MODE) == 0) { ATT_SGB(0x100, 2); _Pragma("unroll") for (int i_ = 0; i_ < 8; ++i_) { ATT_SGB(0x008, 1); ATT_SGB(0x002, 7); ATT_SGB(0x100, 1); } } } while (0)
#define SPARSE_IL_B(MODE) do { if ((MODE) == 0) { ATT_SGB(0x100, 2); _Pragma("unroll") for (int i_ = 0; i_ < 8; ++i_) { ATT_SGB(0x008, 1); ATT_SGB(0x002, 3); ATT_SGB(0x100, 1); } } } while (0)
#define SPARSE_STEP(MODE, j, sPrev, sCur) \
        att_qk(F, sCur, qf, kbase, j); st.l += att_finish(sPrev, st.m - mo, pf); SPARSE_IL_A(MODE); \
        att_pv(F, st.o, pf, vbase, (j) - 1); mx = att_bias_max<MODE>(F, sCur, j, qh, h * 128, cb); SPARSE_IL_B(MODE); att_rescale(st, mx);
#define SPARSE_BODY(MODE) do { \
        f32x16 sA, sB; bf16x8 pf[2]; float mx; const float mo = (MODE == 0) ? cb : 0.f; \
        att_qk(F, sA, qf, kbase, 0); mx = att_bias_max<MODE>(F, sA, 0, qh, h * 128, cb); att_rescale(st, mx); \
        SPARSE_STEP(MODE, 1, sA, sB) SPARSE_STEP(MODE, 2, sB, sA) SPARSE_STEP(MODE, 3, sA, sB) \
        ATT_WAIT_BAR();                                               \
        SPARSE_STEP(MODE, 4, sB, sA) \
        asm volatile("s_waitcnt lgkmcnt(0)" ::: "memory"); __builtin_amdgcn_s_barrier(); asm volatile("" ::: "memory");        \
        if (more) glds_half(F, l2 >> 7, (l2 >> 5) & 3, l2 & 31, 0, 0); \
        SPARSE_STEP(MODE, 5, sA, sB) SPARSE_STEP(MODE, 6, sB, sA) \
        att_qk(F, sB, qf, kbase, 7); st.l += att_finish(sA, st.m - mo, pf); SPARSE_IL_A(MODE); \
        if (more) { SPARSE_FETCH_Q(l2); }                             \
        att_pv(F, st.o, pf, vbase, 6); mx = att_bias_max<MODE>(F, sB, 7, qh, h * 128, cb); SPARSE_IL_B(MODE); att_rescale(st, mx); \
        st.l += att_finish(sB, st.m - mo, pf); att_pv(F, st.o, pf, vbase, 7); } while (0)
        if (far) SPARSE_BODY(0); else SPARSE_BODY(1);
#undef SPARSE_STEP
#undef SPARSE_BODY
#undef SPARSE_IL_A
#undef SPARSE_IL_B
        asm volatile("s_waitcnt vmcnt(8)" ::: "memory");
        __builtin_amdgcn_s_barrier(); asm volatile("" ::: "memory");
        const float lt = st.l + __shfl_xor(st.l, 32); const float inv = 1.0f / lt;
        {
            const unsigned prow = (mrow * NH + h) * 3 + slot;
            int hi2 = F.lane >> 5; asm volatile("" : "+v"(hi2));
            store_row_fp8(st.o, inv, (unsigned char*)OP, prow * (unsigned)HD + 16u * (unsigned)hi2);
            if (hi == 0) ML[prow] = (f32x2){st.m, lt};
        }
        item = item2; l = l2; ++kround;
    }
#undef SPARSE_FETCH_ENT
#undef SPARSE_FETCH_Q
    ATT_WAIT_BAR();
}
__device__ __forceinline__ void p_attn_own(Frame& F) {
    const bf16* QB = (const bf16*)((unsigned char*)F.out + DO_QB); bf16* OB = (bf16*)((unsigned char*)F.out + DO_QB);
    const bf16* OP = (const bf16*)(F.ws + WS_OP); const f32x2* ML = (const f32x2*)(F.ws + WS_ML);
    build_bias_table(F);
    int kbase, vbase; attn_lane_offsets(F.lane, kbase, vbase);
    const int hi = F.lane >> 5;
    for (int item = F.bid; item < BATCH * NKV * NB; item += F.G) {
        const int kvh = item % NKV, j = (item / NKV) % NB, b = item / (NKV * NB);
        glds_half(F, b, kvh, j, 0, 0); glds_half(F, b, kvh, j, 1, 1);
        ATT_WAIT_BAR();
#pragma unroll 1
        for (int task = 0; task < 2; ++task) {
            const int h = 2 * kvh + task, qg = task ? 7 - F.wave : F.wave;
            const int qpos = qg * 32 + (F.lane & 31), t = j * BLK + qpos;
            const unsigned mrow = (unsigned)(b * SEQ + t);
            bf16x8 qf[8];
#pragma unroll
            for (int ks = 0; ks < 8; ++ks) qf[ks] = *(const bf16x8*)(QB + (mrow * D + h * HD + 16 * ks + 8 * hi));
            AttState st; attn_init(st);
            const int ntile = (qg >> 1) + 1;
#pragma unroll 1
            for (int kt = 0; kt < ntile; ++kt) attn_tile<2>(F, st, qf, kbase, vbase, kt, qpos, h * 128, 0.f);
            const float lo = st.l + __shfl_xor(st.l, 32);
            const int nvalid = j < 3 ? j : 3;
            const unsigned prow = (mrow * NH + h) * 3;
            f32x2 ml[3]; float mxx = st.m;
#pragma unroll
            for (int s = 0; s < 3; ++s) { ml[s] = (f32x2){-1.0e30f, 0.f}; if (s < nvalid) { ml[s] = ML[prow + s]; mxx = fmaxf(mxx, ml[s].x); } }
            const float co = fexp2(st.m - mxx); float den = co * lo;
#pragma unroll
            for (int db = 0; db < 4; ++db) st.o[db] = st.o[db] * co;
#pragma unroll
            for (int s = 0; s < 3; ++s) if (s < nvalid) { const float cs = ml[s].y * fexp2(ml[s].x - mxx); den += cs;
                addrow_fp8(st.o, cs, (const unsigned char*)OP + (size_t)(prow + s) * HD, hi); }
            const float inv = 1.0f / den;
            bf16* ob = F.dry ? (bf16*)(F.ws + WS_LIST) + ((mrow & 8191u) * D + h * HD) : OB + (mrow * D + h * HD);
            store_row16(st.o, inv, ob, hi);
        }
        ATT_WAIT_BAR();
    }
}

__global__ void __launch_bounds__(512, 2) yoco_fwd(Args args) {
    extern __shared__ __attribute__((aligned(16))) unsigned char lds_raw[];
    Frame F;
    F.lds = (LAS unsigned char*)lds_raw;
    F.tid = threadIdx.x; F.lane = F.tid & 63; F.wave = __builtin_amdgcn_readfirstlane(F.tid >> 6); F.G = gridDim.x;
    F.out = args.out; F.ws = args.ws; F.kp = (const CAS unsigned char*)__builtin_amdgcn_kernarg_segment_ptr();
    unsigned char* ws = args.ws;
    for (int u = F.tid; u < (LDS_BYTES - LDSCTL_OFF) / 4; u += 512) ((LAS unsigned*)(F.lds + LDSCTL_OFF))[u] = 0u;
    __syncthreads();
    volatile LAS unsigned* MISC = (volatile LAS unsigned*)(F.lds + MISC_OFF);
    XcdBarrier bar; bar.bar = (unsigned*)(ws + WS_CTL) + CW_BAR; bar.x = 0; bar.st = nullptr;
    const int lo = args.ph_lo, hi = args.ph_hi;
    if (hi - lo > 1) bar = xcd_barrier_post((unsigned*)(ws + WS_CTL) + CW_BAR, MISC + 8);
#ifndef PHASE_MASK
#define PHASE_MASK 0xffffffffu
#endif
#define EN(k) (((PHASE_MASK) >> (k)) & 1u)
    const bool fused = gridDim.x == 256;
    const int hi_eff = (fused && hi == 23) ? 22 : hi;
    for (int pid = lo; pid < hi; ++pid) {
      if (pid == 3 || pid == 5 || pid == 14) continue;
      if (fused && (pid == 9 || pid == 12 || pid == 19 || pid == 22)) continue;
      const int nrep = 1 + (int)((REPEAT_SET >> pid) & 1u);
      for (int rep = 0; rep < nrep; ++rep) {
        fresh_ids(F); ws = F.ws; F.dry = rep;
        const int cid = F.bid;
        float* MOD0 = (float*)(ws + WS_MOD0); float* MOD1 = (float*)(ws + WS_MOD1); float* KVMOD = (float*)(ws + WS_KVMOD);
        switch (pid) {
        case 0: if (EN(0)) { p_modgemv(F); } break;
        case 1: if (EN(1)) { p_weights(F, 0, F.bid * 8 + F.wave, F.G * 8); norm_mod_rows<1, false>(F, ARG_IN(F, I_X), ARG_IN(F, I_NMIX), MOD0, MOD0 + D, 6 * D, (bf16*)(ws + WS_H_L0), nullptr, nullptr, nullptr, 0, nullptr); } break;
        case 2: if (EN(2)) { pg8::Gemm g{(const bf16*)(ws + WS_H_L0), (const bf16*)(ws + WS_WIN), M, 2 * LW, D, D}; pg8::StaticOrder S; S.init(M, 2 * LW, F.G, cid);
                pg8::EpiInProjConv E{(bf16*)(ws + WS_Y), (bf16*)(ws + WS_XC), (bf16*)(ws + WS_RAWS), ARG_IN(F, I_CONVW), ARG_IN(F, I_CONVB)};
                pg8::gemm_phase<pg8::EpiInProjConv, pg8::StaticOrder, true>(F.lds + RING_OFF, g, S, E); p_weights_bubble(F, 1); } break;
        case 3: break;
        case 4: if (EN(4)) { fixup_conv_rows(F);
                pg8::Gemm g{(const bf16*)(ws + WS_XC), (const bf16*)(ws + WS_WG), M, 2 * LW, LB, LW}; pg8::GatesOrder S{F.G, cid};
                pg8::EpiGates E{(const bf16*)(ws + WS_XC), (bf16*)(ws + WS_XB), (bf16*)(ws + WS_BB), ARG_IN(F, I_BGATES), ARG_IN(F, I_BGATES) + LW, (const float*)(ws + WS_C8), (float*)(ws + WS_SA), (float*)(ws + WS_SB)};
                pg8::gemm_phase<pg8::EpiGates, pg8::GatesOrder, true>(F.lds + RING_OFF, g, S, E); p_weights_bubble(F, 2); } break;
        case 5: break;
        case 6: if (EN(6)) p_scan_carry(F); break;
        case 7: if (EN(6)) p_scan2(F); break;
        case 8: case 18: if (EN(7)) { const int layer = pid == 18; float* MOD = layer ? MOD1 : MOD0;
                pg8::StaticOrder S; S.init(M, D, F.G, cid);
                pg8::Gemm g = layer == 0 ? pg8::Gemm{(const bf16*)(ws + WS_Y), (const bf16*)(ws + WS_WOUT), M, D, LW, LW} : pg8::Gemm{(const bf16*)((unsigned char*)F.out + DO_QB), (const bf16*)(ws + WS_WO), M, D, D, D};
                if (fused) {
                    pg8::RowSumSq st{(unsigned long long*)(ws + WS_XCHG) + (size_t)(layer ? 2 : 0) * 65536, (unsigned*)(ws + WS_CTL) + CW_SEAM + (layer ? 2 : 0) * 4096, (unsigned*)(ws + WS_CTL) + CW_TMO_X};
                    pg8::EpiResidNorm E{layer ? (const void*)(ws + WS_XS) : (const void*)ARG_IN(F, I_X), layer, (bf16*)(ws + WS_XS), MOD + 2 * D, 6 * D, st, 0, nullptr,
                                        1, (bf16*)(ws + (layer ? WS_H_F1 : WS_H_F0)), ARG_IN(F, I_NFFN) + layer * D, MOD + 3 * D, MOD + 4 * D, 6 * D, nullptr, nullptr, nullptr, nullptr, 0};
                    pg8::gemm_phase<pg8::EpiResidNorm, pg8::StaticOrder, true>(F.lds + RING_OFF, g, S, E);
                } else {
                    pg8::EpiResid E = layer == 0 ? pg8::EpiResid{ARG_IN(F, I_X), ws + WS_XS, MOD + 2 * D, 6 * D, 0, 1} : pg8::EpiResid{ws + WS_XS, ws + WS_XS, MOD + 2 * D, 6 * D, 1, 1};
                    pg8::gemm_phase<pg8::EpiResid, pg8::StaticOrder, true>(F.lds + RING_OFF, g, S, E); } } break;
        case 9: case 19: if (EN(8)) { const int layer = pid == 19; float* MOD = layer ? MOD1 : MOD0;
                norm_mod_rows<1, true>(F, ws + WS_XS, ARG_IN(F, I_NFFN) + layer * D, MOD + 3 * D, MOD + 4 * D, 6 * D, (bf16*)(ws + (layer ? WS_H_F1 : WS_H_F0)), nullptr, nullptr, nullptr, 0, nullptr); } break;
        case 10: case 20: if (EN(9)) { const int layer = pid == 20;
                pg8::Gemm g{(const bf16*)(ws + (layer ? WS_H_F1 : WS_H_F0)), (const bf16*)(ws + (layer ? WS_WGU1 : WS_WGU0)), M, 2 * FF, D, D}; pg8::TailSplitOrder S; S.init(M, 2 * FF, F.G, cid);
                pg8::EpiSwiGLU E{(bf16*)(ws + (layer ? WS_HF1 : WS_HF0))};
                pg8::gemm_phase<pg8::EpiSwiGLU, pg8::TailSplitOrder, true>(F.lds + RING_OFF, g, S, E); } break;
        case 11: case 21: if (EN(10)) { const int layer = pid == 21; float* MOD = layer ? MOD1 : MOD0;
                pg8::Gemm g{(const bf16*)(ws + (layer ? WS_HF1 : WS_HF0)), (const bf16*)(ws + (layer ? WS_WD1 : WS_WD0)), M, D, FF, FF}; pg8::StaticOrder S; S.init(M, D, F.G, cid);
                if (fused) {
                    pg8::RowSumSq st{(unsigned long long*)(ws + WS_XCHG) + (size_t)(layer ? 3 : 1) * 65536, (unsigned*)(ws + WS_CTL) + CW_SEAM + (layer ? 3 : 1) * 4096, (unsigned*)(ws + WS_CTL) + CW_TMO_X};
                    pg8::EpiResidNorm E = layer == 0
                        ? pg8::EpiResidNorm{ws + WS_XS, 1, (bf16*)(ws + WS_XS), MOD + 5 * D, 6 * D, st, 0, nullptr, 2, (bf16*)(ws + WS_HKV), ARG_IN(F, I_KVNORM), KVMOD, KVMOD + D, 2 * D, (bf16*)(ws + WS_H_L1), ARG_IN(F, I_NMIX) + D, MOD1, MOD1 + D, 6 * D}
                        : pg8::EpiResidNorm{ws + WS_XS, 1, (bf16*)(ws + WS_XS), MOD + 5 * D, 6 * D, st, 1, F.out, 0, nullptr, ARG_IN(F, I_FNORM), nullptr, nullptr, 0, nullptr, nullptr, nullptr, nullptr, 0};
                    pg8::gemm_phase<pg8::EpiResidNorm, pg8::StaticOrder, true>(F.lds + RING_OFF, g, S, E);
                } else {
                    pg8::EpiResid E{ws + WS_XS, layer ? (void*)F.out : (void*)(ws + WS_XS), MOD + 5 * D, 6 * D, 1, layer ? 0 : 1};
                    pg8::gemm_phase<pg8::EpiResid, pg8::StaticOrder, true>(F.lds + RING_OFF, g, S, E); } } break;
        case 12: if (EN(11)) norm_mod_rows<2, true>(F, ws + WS_XS, ARG_IN(F, I_KVNORM), KVMOD, KVMOD + D, 2 * D, (bf16*)(ws + WS_HKV), ARG_IN(F, I_NMIX) + D, MOD1, MOD1 + D, 6 * D, (bf16*)(ws + WS_H_L1)); break;
        case 13: if (EN(12)) {
                for (int g3 = 0; g3 < 3; ++g3) {
                    pg8::Gemm g; pg8::EpiPlain E; pg8::StaticOrder S;
                    if (g3 == 0) { g = pg8::Gemm{(const bf16*)(ws + WS_HKV), (const bf16*)(ws + WS_WKV), M, NKV * HD, D, D}; E = pg8::EpiPlain{(bf16*)((unsigned char*)F.out + DO_KB), NKV * HD, 1.0f, (float*)(ws + WS_KMP)}; S.init(M, NKV * HD, F.G, cid); }
                    else if (g3 == 1) { g = pg8::Gemm{(const bf16*)(ws + WS_WKV) + (size_t)(NKV * HD) * D, (const bf16*)(ws + WS_HKV), NKV * HD, M, D, D}; E = pg8::EpiPlain{(bf16*)((unsigned char*)F.out + DO_VT), M, 1.0f, nullptr};
                        S.init(NKV * HD, M, F.G, F.G >= 256 ? (cid + 128) % F.G : cid); }
                    else { g = pg8::Gemm{(const bf16*)(ws + WS_H_L1), (const bf16*)(ws + WS_WQ), M, D, D, D}; E = pg8::EpiPlain{(bf16*)((unsigned char*)F.out + DO_QB), D, 0.08838834764831845f * LOG2E, nullptr}; S.init(M, D, F.G, cid); }
                    pg8::gemm_phase<pg8::EpiPlain, pg8::StaticOrder, true>(F.lds + RING_OFF, g, S, E);
                } } break;
        case 14: break;
        case 15: if (EN(14)) p_gate(F); break;
        case 16: if (EN(15)) p_attn_sparse(F); break;
        case 17: if (EN(16)) p_attn_own(F); break;
        default: if (EN(22)) final_norm_rows(F, F.out, F.dry ? (float*)(ws + ACT) : F.out, ARG_IN(F, I_FNORM)); break;
        }
        if (pid + 1 < hi_eff || rep + 1 < nrep) { bar.bar = (unsigned*)(ws + WS_CTL) + CW_BAR; xcd_barrier(bar); }
      }
    }
}
constexpr int N_PHASES = 23;

extern "C" void kernel_launch(void* const* d_in, const int* in_sizes, int n_in, void* d_out, int out_size, void* d_ws, size_t ws_size, hipStream_t stream) {
    static int grid = 0;
    if (grid == 0) {
        if (n_in != 24 || out_size != M * D || ws_size < WS_END) { fprintf(stderr, "kernel_launch: unexpected shapes (n_in %d out %d ws %zu)\n", n_in, out_size, ws_size); grid = -1; return; }
        int dev = 0, cus = 0;
        if (hipGetDevice(&dev) != hipSuccess || hipDeviceGetAttribute(&cus, hipDeviceAttributeMultiprocessorCount, dev) != hipSuccess) { grid = -1; return; }
        if (hipFuncSetAttribute((const void*)yoco_fwd, hipFuncAttributeMaxDynamicSharedMemorySize, LDS_BYTES) != hipSuccess) { fprintf(stderr, "kernel_launch: hipFuncSetAttribute failed\n"); grid = -1; return; }
        (void)hipGetLastError();
        grid = cus;
    }
    if (grid < 0) return;
    if (hipMemsetAsync((char*)d_ws + WS_CTL, 0, CTL_ZERO_BYTES, stream) != hipSuccess) return;
    Args a{};
    for (int i = 0; i < 24; ++i) a.in[i] = (const float*)d_in[i];
    a.out = (float*)d_out; a.ws = (unsigned char*)d_ws;
#if MK_N_LAUNCHES == 1
    a.ph_lo = 0; a.ph_hi = N_PHASES;
    hipLaunchKernelGGL(yoco_fwd, dim3(grid), dim3(512), LDS_BYTES, stream, a);
#else
    for (int p = 0; p < N_PHASES; ++p) { a.ph_lo = p; a.ph_hi = p + 1; hipLaunchKernelGGL(yoco_fwd, dim3(grid), dim3(512), LDS_BYTES, stream, a); }
#endif
}
```
